# Optimizing an MI355X kernel written in HIP

```python
import math
import jax
import jax.numpy as jnp
from jax import lax
import numpy as np


D_MODEL = 2048
BATCH = 2
SEQ = 8192
DEPTH = 1

N_META = 16
NORM_EPS = 1e-5

SSM_WIDTH = D_MODEL // 2
SSM_GROUP = 16
SSM_GROUPS = SSM_WIDTH // SSM_GROUP
SSM_STATE = 64
DT_MIN = 1e-3
DT_MAX = 1e-1

ATTN_HEADS = 8
ATTN_HEAD_DIM = 64
ATTN_V_DIM = 2 * ATTN_HEAD_DIM
ATTN_QK_WIDTH = ATTN_HEADS * 2 * ATTN_HEAD_DIM
ATTN_V_WIDTH = ATTN_HEADS * ATTN_V_DIM
Q_BLOCK = 128
ALIBI_MAX_EXP = 8.0

N_EXPERTS = 32
TOP_K = 4
D_FF = D_MODEL
SWIGLU_LIMIT = 7.0
SWIGLU_ALPHA = 1.702
MOE_BLOCK = 128

IN_COLS = SSM_WIDTH + 2 * ATTN_QK_WIDTH + ATTN_V_WIDTH + 2 * D_MODEL

kernel_name = 'hybrid_s5_diffattn_moe_encoder'


def _rmsnorm(x, g):
    xf = x.astype(jnp.float32)
    y = xf * lax.rsqrt(jnp.mean(xf * xf, axis=-1, keepdims=True) + NORM_EPS)
    return (y * g.astype(jnp.float32)).astype(x.dtype)


def _complex_affine_combine(e1, e2):
    a1r, a1i, b1r, b1i = e1
    a2r, a2i, b2r, b2i = e2
    return (a2r * a1r - a2i * a1i,
            a2r * a1i + a2i * a1r,
            a2r * b1r - a2i * b1i + b2r,
            a2r * b1i + a2i * b1r + b2i)


def _s5_direction(u, lam_re, lam_im, log_dt, b_re, b_im, c_re, c_im, reverse):
    f32 = jnp.float32
    lam_re = lam_re.astype(f32)
    lam_im = lam_im.astype(f32)
    b_re = b_re.astype(f32)
    b_im = b_im.astype(f32)
    dt = jnp.exp(log_dt.astype(f32))[:, None]
    mag = jnp.exp(lam_re * dt)
    ar = mag * jnp.cos(lam_im * dt)
    ai = mag * jnp.sin(lam_im * dt)
    den = lam_re * lam_re + lam_im * lam_im
    fr = ((ar - 1.0) * lam_re + ai * lam_im) / den
    fi = (ai * lam_re - (ar - 1.0) * lam_im) / den
    bb_re = fr[..., None] * b_re - fi[..., None] * b_im
    bb_im = fr[..., None] * b_im + fi[..., None] * b_re
    drive_re = jnp.einsum('blgi,gpi->blgp', u, bb_re)
    drive_im = jnp.einsum('blgi,gpi->blgp', u, bb_im)
    seq_len = u.shape[1]
    a_shape = (1, seq_len) + ar.shape
    a_re = jnp.broadcast_to(ar, a_shape)
    a_im = jnp.broadcast_to(ai, a_shape)
    _, _, h_re, h_im = lax.associative_scan(
        _complex_affine_combine, (a_re, a_im, drive_re, drive_im), reverse=reverse, axis=1)
    return (jnp.einsum('blgp,gop->blgo', h_re, c_re.astype(f32))
            - jnp.einsum('blgp,gop->blgo', h_im, c_im.astype(f32)))


def _diff_attention(q, k, v, lam, lam_init, subln_g):
    f32 = jnp.float32
    bsz, seq_len = q.shape[0], q.shape[1]
    n_blocks = -(-seq_len // Q_BLOCK)
    l_pad = n_blocks * Q_BLOCK
    q_pad = jnp.pad(q, ((0, 0), (0, l_pad - seq_len), (0, 0), (0, 0), (0, 0)))
    q_blocks = q_pad.reshape(bsz, n_blocks, Q_BLOCK, ATTN_HEADS, 2, ATTN_HEAD_DIM)
    q_blocks = q_blocks.transpose(1, 0, 2, 3, 4, 5)
    starts = jnp.arange(n_blocks, dtype=jnp.int32) * Q_BLOCK
    key_pos = jnp.arange(seq_len, dtype=jnp.int32)
    slopes = jnp.exp2(-ALIBI_MAX_EXP * jnp.arange(1, ATTN_HEADS + 1, dtype=f32) / ATTN_HEADS)
    scale = ATTN_HEAD_DIM ** -0.5

    def block(args):
        qb, start = args
        qpos = start + jnp.arange(Q_BLOCK, dtype=jnp.int32)
        dist = jnp.abs(qpos[:, None] - key_pos[None, :]).astype(f32)
        is_meta = (qpos[:, None] < N_META) | (key_pos[None, :] < N_META)
        dist = jnp.where(is_meta, 0.0, dist)
        s = jnp.einsum('bqhcd,bkhcd->bhcqk', qb, k).astype(f32) * scale
        s = s - slopes[:, None, None, None] * dist
        p = jax.nn.softmax(s, axis=-1)
        a = p[:, :, 0] - lam * p[:, :, 1]
        return jnp.einsum('bhqk,bkhe->bqhe', a.astype(v.dtype), v)

    o = lax.map(block, (q_blocks, starts))
    o = o.transpose(1, 0, 2, 3, 4).reshape(bsz, l_pad, ATTN_HEADS, ATTN_V_DIM)[:, :seq_len]
    o = _rmsnorm(o, subln_g) * (1.0 - lam_init)
    return o.reshape(bsz, seq_len, ATTN_V_WIDTH)


def _moe(xf, w_router, b_router, w1, b1, w2, b2):
    f32 = jnp.float32
    n_tok = xf.shape[0]
    logits = (xf @ w_router).astype(f32) + b_router.astype(f32)
    top_vals, top_idx = lax.top_k(logits, TOP_K)
    gates = jax.nn.softmax(top_vals, axis=-1)
    n_assign = n_tok * TOP_K
    e_flat = top_idx.reshape(n_assign)
    tok_flat = jnp.broadcast_to(jnp.arange(n_tok, dtype=jnp.int32)[:, None], (n_tok, TOP_K)).reshape(n_assign)
    g_flat = gates.reshape(n_assign)
    order = jnp.argsort(e_flat)
    e_sorted = e_flat[order]
    tok_sorted = tok_flat[order]
    g_sorted = g_flat[order]
    counts = jnp.bincount(e_flat, length=N_EXPERTS)
    padded = ((counts + MOE_BLOCK - 1) // MOE_BLOCK) * MOE_BLOCK
    pad_end = jnp.cumsum(padded)
    pad_start = pad_end - padded
    cnt_start = jnp.cumsum(counts) - counts
    slot = pad_start[e_sorted] + (jnp.arange(n_assign, dtype=jnp.int32) - cnt_start[e_sorted])
    n_blocks = -(-n_assign // MOE_BLOCK) + N_EXPERTS
    n_slots = n_blocks * MOE_BLOCK
    slot_tok = jnp.zeros((n_slots,), jnp.int32).at[slot].set(tok_sorted)
    slot_gate = jnp.zeros((n_slots,), f32).at[slot].set(g_sorted)
    block_start = jnp.arange(n_blocks, dtype=jnp.int32) * MOE_BLOCK
    block_expert = jnp.minimum(jnp.searchsorted(pad_end, block_start, side='right'), N_EXPERTS - 1)

    def run_block(args):
        tok, gate_b, e = args
        xb = xf[tok]
        hdn = xb @ w1[e] + b1[e]
        x_glu = jnp.minimum(hdn[:, 0::2], SWIGLU_LIMIT)
        x_lin = jnp.clip(hdn[:, 1::2], -SWIGLU_LIMIT, SWIGLU_LIMIT)
        act = x_glu * jax.nn.sigmoid(SWIGLU_ALPHA * x_glu) * (x_lin + 1.0)
        y = act @ w2[e] + b2[e]
        return y * gate_b[:, None].astype(y.dtype)

    ys = lax.map(run_block, (slot_tok.reshape(n_blocks, MOE_BLOCK),
                             slot_gate.reshape(n_blocks, MOE_BLOCK), block_expert))
    return jnp.zeros_like(xf).at[slot_tok].add(ys.reshape(n_slots, xf.shape[1]).astype(xf.dtype))


def setup_inputs(seed: int = 0) -> dict:
    key = jax.random.key(seed)
    ks = jax.random.split(key, 40)
    f32 = jnp.float32

    def nrm(k, shape, scale):
        return scale * jax.random.normal(k, shape, f32)

    n_idx = jnp.arange(SSM_STATE, dtype=f32)

    def ssm_params(k0):
        kk = jax.random.split(k0, 7)
        lam_re = -0.5 + nrm(kk[0], (DEPTH, SSM_GROUPS, SSM_STATE), 0.01)
        lam_im = math.pi * n_idx + nrm(kk[1], (DEPTH, SSM_GROUPS, SSM_STATE), 0.01)
        log_dt = math.log(DT_MIN) + jax.random.uniform(kk[2], (DEPTH, SSM_GROUPS), f32) * (math.log(DT_MAX) - math.log(DT_MIN))
        b_re = nrm(kk[3], (DEPTH, SSM_GROUPS, SSM_STATE, SSM_GROUP), (2 * SSM_GROUP) ** -0.5)
        b_im = nrm(kk[4], (DEPTH, SSM_GROUPS, SSM_STATE, SSM_GROUP), (2 * SSM_GROUP) ** -0.5)
        c_re = nrm(kk[5], (DEPTH, SSM_GROUPS, SSM_GROUP, SSM_STATE), SSM_STATE ** -0.5)
        c_im = nrm(kk[6], (DEPTH, SSM_GROUPS, SSM_GROUP, SSM_STATE), SSM_STATE ** -0.5)
        return lam_re, lam_im, log_dt, b_re, b_im, c_re, c_im

    fw = ssm_params(ks[4])
    bw = ssm_params(ks[5])
    return {
        'x': nrm(ks[0], (BATCH, SEQ, D_MODEL), 1.0),
        'meta_tokens': nrm(ks[1], (N_META, D_MODEL), 1.0),
        'norm_mix_g': 1.0 + nrm(ks[2], (DEPTH, D_MODEL), 0.02),
        'w_in': nrm(ks[3], (DEPTH, D_MODEL, IN_COLS), D_MODEL ** -0.5),
        'ssm_lam_re_f': fw[0], 'ssm_lam_im_f': fw[1], 'ssm_log_dt_f': fw[2],
        'ssm_b_re_f': fw[3], 'ssm_b_im_f': fw[4], 'ssm_c_re_f': fw[5], 'ssm_c_im_f': fw[6],
        'ssm_lam_re_b': bw[0], 'ssm_lam_im_b': bw[1], 'ssm_log_dt_b': bw[2],
        'ssm_b_re_b': bw[3], 'ssm_b_im_b': bw[4], 'ssm_c_re_b': bw[5], 'ssm_c_im_b': bw[6],
        'ssm_d': nrm(ks[6], (DEPTH, SSM_WIDTH), 1.0),
        'w_ssm_glu': nrm(ks[7], (DEPTH, SSM_WIDTH, 2 * D_MODEL), SSM_WIDTH ** -0.5),
        'diff_lam_q1': nrm(ks[8], (DEPTH, ATTN_HEAD_DIM), 0.1),
        'diff_lam_k1': nrm(ks[9], (DEPTH, ATTN_HEAD_DIM), 0.1),
        'diff_lam_q2': nrm(ks[10], (DEPTH, ATTN_HEAD_DIM), 0.1),
        'diff_lam_k2': nrm(ks[11], (DEPTH, ATTN_HEAD_DIM), 0.1),
        'diff_subln_g': 1.0 + nrm(ks[12], (DEPTH, ATTN_V_DIM), 0.02),
        'w_attn_out': nrm(ks[13], (DEPTH, ATTN_V_WIDTH, D_MODEL), ATTN_V_WIDTH ** -0.5),
        'w_out': nrm(ks[14], (DEPTH, D_MODEL, D_MODEL), D_MODEL ** -0.5),
        'norm_moe_g': 1.0 + nrm(ks[15], (DEPTH, D_MODEL), 0.02),
        'w_router': nrm(ks[16], (DEPTH, D_MODEL, N_EXPERTS), D_MODEL ** -0.5),
        'b_router': nrm(ks[17], (DEPTH, N_EXPERTS), 0.01),
        'w_exp1': nrm(ks[18], (DEPTH, N_EXPERTS, D_MODEL, 2 * D_FF), D_MODEL ** -0.5),
        'b_exp1': nrm(ks[19], (DEPTH, N_EXPERTS, 2 * D_FF), 0.01),
        'w_exp2': nrm(ks[20], (DEPTH, N_EXPERTS, D_FF, D_MODEL), D_FF ** -0.5),
        'b_exp2': nrm(ks[21], (DEPTH, N_EXPERTS, D_MODEL), 0.01),
        'norm_final_g': 1.0 + nrm(ks[22], (D_MODEL,), 0.02),
    }


def reference(x, meta_tokens, norm_mix_g, w_in,
              ssm_lam_re_f, ssm_lam_im_f, ssm_log_dt_f, ssm_b_re_f, ssm_b_im_f, ssm_c_re_f, ssm_c_im_f,
              ssm_lam_re_b, ssm_lam_im_b, ssm_log_dt_b, ssm_b_re_b, ssm_b_im_b, ssm_c_re_b, ssm_c_im_b,
              ssm_d, w_ssm_glu,
              diff_lam_q1, diff_lam_k1, diff_lam_q2, diff_lam_k2, diff_subln_g, w_attn_out,
              w_out, norm_moe_g, w_router, b_router, w_exp1, b_exp1, w_exp2, b_exp2, norm_final_g):
    f32 = jnp.float32
    bsz = x.shape[0]
    meta = jnp.broadcast_to(meta_tokens.astype(x.dtype)[None], (bsz, N_META, D_MODEL))
    h = jnp.concatenate([meta, x], axis=1)
    seq_len = h.shape[1]
    c0 = SSM_WIDTH
    c1 = c0 + ATTN_QK_WIDTH
    c2 = c1 + ATTN_QK_WIDTH
    c3 = c2 + ATTN_V_WIDTH
    c4 = c3 + D_MODEL
    for layer in range(DEPTH):
        xn = _rmsnorm(h, norm_mix_g[layer])
        proj = xn @ w_in[layer]
        u, q, k, v, gate_s, gate_a = jnp.split(proj, [c0, c1, c2, c3, c4], axis=-1)

        uf = u.astype(f32)
        ug = uf.reshape(bsz, seq_len, SSM_GROUPS, SSM_GROUP)
        y = (_s5_direction(ug, ssm_lam_re_f[layer], ssm_lam_im_f[layer], ssm_log_dt_f[layer],
                           ssm_b_re_f[layer], ssm_b_im_f[layer], ssm_c_re_f[layer], ssm_c_im_f[layer], False)
             + _s5_direction(ug, ssm_lam_re_b[layer], ssm_lam_im_b[layer], ssm_log_dt_b[layer],
                             ssm_b_re_b[layer], ssm_b_im_b[layer], ssm_c_re_b[layer], ssm_c_im_b[layer], True))
        y = y.reshape(bsz, seq_len, SSM_WIDTH) + ssm_d[layer].astype(f32) * uf
        y = jax.nn.gelu(y).astype(h.dtype)
        glu_a, glu_b = jnp.split(y @ w_ssm_glu[layer], 2, axis=-1)
        y_ssm = glu_a * jax.nn.sigmoid(glu_b)

        lam_init = 0.8 - 0.6 * math.exp(-0.3 * layer)
        lam = (jnp.exp(jnp.sum(diff_lam_q1[layer].astype(f32) * diff_lam_k1[layer].astype(f32)))
               - jnp.exp(jnp.sum(diff_lam_q2[layer].astype(f32) * diff_lam_k2[layer].astype(f32)))
               + lam_init)
        o = _diff_attention(q.reshape(bsz, seq_len, ATTN_HEADS, 2, ATTN_HEAD_DIM),
                            k.reshape(bsz, seq_len, ATTN_HEADS, 2, ATTN_HEAD_DIM),
                            v.reshape(bsz, seq_len, ATTN_HEADS, ATTN_V_DIM),
                            lam, lam_init, diff_subln_g[layer])
        y_attn = o @ w_attn_out[layer]

        merged = jax.nn.sigmoid(gate_s) * y_ssm + jax.nn.sigmoid(gate_a) * y_attn
        h = h + merged @ w_out[layer]

        hn = _rmsnorm(h, norm_moe_g[layer])
        moe_out = _moe(hn.reshape(bsz * seq_len, D_MODEL), w_router[layer], b_router[layer],
                       w_exp1[layer], b_exp1[layer], w_exp2[layer], b_exp2[layer])
        h = h + moe_out.reshape(bsz, seq_len, D_MODEL)
    h = _rmsnorm(h, norm_final_g)
    return h[:, N_META:]
```

```cpp
#include <hip/hip_runtime.h>
#include <cstdio>
#include <cstdint>

#ifndef MK_FUSED
#define MK_FUSED 1
#endif
#ifndef DBL_MASK
#define DBL_MASK 0
#endif
#ifndef MOE_MX
#define MOE_MX 1
#endif
#ifndef NAIVE_GEMM
#define NAIVE_GEMM 0
#endif
#ifndef NAIVE_ATTN
#define NAIVE_ATTN 0
#endif
#ifndef NAIVE_SSM
#define NAIVE_SSM 0
#endif

#define LAS __attribute__((address_space(3)))
#define GAS __attribute__((address_space(1)))
typedef unsigned short bf16_t;
typedef short bf16x8 __attribute__((ext_vector_type(8)));
typedef short s16x4 __attribute__((ext_vector_type(4)));
typedef float f32x2 __attribute__((ext_vector_type(2)));
typedef float f32x4 __attribute__((ext_vector_type(4)));
typedef float f32x16 __attribute__((ext_vector_type(16)));
typedef unsigned u32x2 __attribute__((ext_vector_type(2)));
typedef unsigned u32x4 __attribute__((ext_vector_type(4)));
typedef int i32x4_t __attribute__((ext_vector_type(4)));
typedef __bf16 bf16x2_t __attribute__((ext_vector_type(2)));

constexpr int NB = 2, SEQ = 8192, DM = 2048, MTOK = NB * SEQ, NMETA = 16;
constexpr int SSMW = 1024, NGRP = 64, GSZ = 16, NST = 64, CHUNK = 32, NCHUNK = SEQ / CHUNK  , GROWS = NB * NCHUNK  , UEXT_LD = 768;
constexpr int NHEAD = 8, DH = 64, DV = 128, NHC = 16;
constexpr int NEXP = 32, TOPK = 4, DFF = 2048;
constexpr int INCOLS = 8192;
constexpr float EPS = 1e-5f;
constexpr float LOG2E = 1.4426950408889634f;
constexpr float QSCALE = 0.125f * LOG2E;
constexpr int MAXSLOT = MTOK * TOPK + NEXP * 256;

constexpr size_t MiB = 1u << 20;
constexpr size_t WS_CTL = 0, CTL_ZERO_BYTES = 1 * MiB;
constexpr size_t WS_MISC = 1 * MiB;
constexpr size_t MISC_XNM = 4096, MISC_UM = 128 * 1024, MISC_KM = 256 * 1024, MISC_VM = 384 * 1024, MISC_WRT = 512 * 1024;
constexpr size_t WS_WIN = 16 * MiB, WS_WGLU = 48 * MiB, WS_WAO = 56 * MiB, WS_WOUT = 60 * MiB, WS_BT3 = 68 * MiB, WS_WST = 116 * MiB;
constexpr size_t WS_XN = 132 * MiB, WS_UEXT = 196 * MiB, WS_Q = 244 * MiB, WS_K = 276 * MiB, WS_V = 308 * MiB, WS_GS = 340 * MiB, WS_GA = 404 * MiB;
constexpr size_t WS_S = 468 * MiB, WS_Y = 500 * MiB, WS_OP = 532 * MiB, WS_O = 660 * MiB, WS_T2 = 692 * MiB, WS_MRG = 756 * MiB, WS_HN = 820 * MiB;
constexpr size_t WS_ROUTE = 884 * MiB;
constexpr size_t RT_E = 0, RT_RANK = 256 * 1024, RT_GATE = 512 * 1024, RT_SLOT = 768 * 1024, RT_STOK = 1024 * 1024, RT_SGATE = 1536 * 1024;
constexpr size_t WS_ACT = 888 * MiB, WS_YS = 1192 * MiB, WS_WE1 = 1496 * MiB, WS_WE2 = 2008 * MiB, WS_YF = 2264 * MiB, WS_XNQ = 2328 * MiB  , WS_XNS = 2360 * MiB  , WS_WGQ = 2362 * MiB  , WS_WGS = 2370 * MiB, WS_HNL = 2372 * MiB  , WS_HNLS = 3396 * MiB  , WS_END = 3428 * MiB;
constexpr int CW_TMO = 0, CW_CNT = 64  , CW_Q0 = 128  , CW_AQ = 160  , CW_NRM = 192  , CW_BAR = 4096;

constexpr int RING_BYTES = 139264  , LDSCTL_OFF = RING_BYTES, MISC_OFF = LDSCTL_OFF + 320, LDS_BYTES = 147456;
static_assert(MISC_OFF + 128 <= LDS_BYTES && (2 * 33 * 64 * 2 + 2 * 64 * 16 * 2 + 2 * 16 * 64 * 2 + 2 * 32 * 16 * 16) * 4 <= RING_BYTES && 8 * 16896 <= RING_BYTES, "LDS map");
constexpr int NWAVES = 8, NTHREADS = 512;

__device__ __forceinline__ unsigned pk_bf16(float lo, float hi) { f32x2 v = {lo, hi}; bf16x2_t b = __builtin_convertvector(v, bf16x2_t); return __builtin_bit_cast(unsigned, b); }
__device__ __forceinline__ float bf_lo(unsigned w) { return __uint_as_float(w << 16); }
__device__ __forceinline__ float bf_hi(unsigned w) { return __uint_as_float(w & 0xffff0000u); }
__device__ __forceinline__ float bf2f(bf16_t b) { return __uint_as_float(((unsigned)b) << 16); }
__device__ __forceinline__ void unpack8(const u32x4 w, float (&f)[8]) { f[0] = bf_lo(w.x); f[1] = bf_hi(w.x); f[2] = bf_lo(w.y); f[3] = bf_hi(w.y); f[4] = bf_lo(w.z); f[5] = bf_hi(w.z); f[6] = bf_lo(w.w); f[7] = bf_hi(w.w); }
__device__ __forceinline__ u32x4 pack8(const float (&f)[8]) { u32x4 w; w.x = pk_bf16(f[0], f[1]); w.y = pk_bf16(f[2], f[3]); w.z = pk_bf16(f[4], f[5]); w.w = pk_bf16(f[6], f[7]); return w; }
__device__ __forceinline__ void ld8bf(const bf16_t* p, float (&f)[8]) { unpack8(*(const u32x4*)p, f); }
__device__ __forceinline__ void st8bf(bf16_t* p, const float (&f)[8]) { *(u32x4*)p = pack8(f); }
__device__ __forceinline__ float sigmoidf_fast(float x) { return __builtin_amdgcn_rcpf(1.0f + __builtin_amdgcn_exp2f(-x * LOG2E)); }
__device__ __forceinline__ float wave_sum(float v) {
#pragma unroll
    for (int o = 1; o < 64; o <<= 1) v += __shfl_xor(v, o);
    return v;
}
__device__ __forceinline__ unsigned mx_scale_byte(float amax) { const int f = (int)((__float_as_uint(amax) >> 23) & 0xffu) - 7; return (unsigned)(f < 0 ? 0 : f); }
__device__ __forceinline__ float mx_inv_scale(unsigned sbyte) { return __uint_as_float((254u - sbyte) << 23); }
__device__ __forceinline__ int mx_phys(int kk) { return kk; }
__device__ __forceinline__ unsigned fp8x4(float a, float b, float c, float d) { int w = 0; w = __builtin_amdgcn_cvt_pk_fp8_f32(a, b, w, false); w = __builtin_amdgcn_cvt_pk_fp8_f32(c, d, w, true); return (unsigned)w; }
__device__ __forceinline__ float max_x16_x32(float v) {
    { auto r = __builtin_amdgcn_permlane16_swap(__float_as_uint(v), __float_as_uint(v), false, false); v = fmaxf(__uint_as_float(r[0]), __uint_as_float(r[1])); }
    { auto r = __builtin_amdgcn_permlane32_swap(__float_as_uint(v), __float_as_uint(v), false, false); v = fmaxf(__uint_as_float(r[0]), __uint_as_float(r[1])); }
    return v;
}
template <int CTRL> __device__ __forceinline__ float dpp_f(float v) { return __uint_as_float((unsigned)__builtin_amdgcn_update_dpp(0, (int)__float_as_uint(v), CTRL, 0xF, 0xF, true)); }
template <int CTRL> __device__ __forceinline__ int dpp_i(int v) { return __builtin_amdgcn_update_dpp(0, v, CTRL, 0xF, 0xF, true); }
__device__ __forceinline__ float wave_sum_dpp(float v) {
    v += dpp_f<0xB1>(v); v += dpp_f<0x4E>(v); v += dpp_f<0x141>(v); v += dpp_f<0x140>(v);
    { auto r = __builtin_amdgcn_permlane16_swap(__float_as_uint(v), __float_as_uint(v), false, false); v = __uint_as_float(r[0]) + __uint_as_float(r[1]); }
    { auto r = __builtin_amdgcn_permlane32_swap(__float_as_uint(v), __float_as_uint(v), false, false); v = __uint_as_float(r[0]) + __uint_as_float(r[1]); }
    return v;
}
__device__ __forceinline__ void amax_step(float& bv, int& bi, float ov, int oi) { const bool tk = (ov > bv) || (ov == bv && oi < bi); bv = tk ? ov : bv; bi = tk ? oi : bi; }
__device__ __forceinline__ void wave_argmax_dpp(float& bv, int& bi) {
    amax_step(bv, bi, dpp_f<0xB1>(bv), dpp_i<0xB1>(bi)); amax_step(bv, bi, dpp_f<0x4E>(bv), dpp_i<0x4E>(bi));
    amax_step(bv, bi, dpp_f<0x141>(bv), dpp_i<0x141>(bi)); amax_step(bv, bi, dpp_f<0x140>(bv), dpp_i<0x140>(bi));
    { auto rv = __builtin_amdgcn_permlane16_swap(__float_as_uint(bv), __float_as_uint(bv), false, false); auto ri = __builtin_amdgcn_permlane16_swap((unsigned)bi, (unsigned)bi, false, false);
      bv = __uint_as_float(rv[0]); bi = (int)ri[0]; amax_step(bv, bi, __uint_as_float(rv[1]), (int)ri[1]); }
    { auto rv = __builtin_amdgcn_permlane32_swap(__float_as_uint(bv), __float_as_uint(bv), false, false); auto ri = __builtin_amdgcn_permlane32_swap((unsigned)bi, (unsigned)bi, false, false);
      bv = __uint_as_float(rv[0]); bi = (int)ri[0]; amax_step(bv, bi, __uint_as_float(rv[1]), (int)ri[1]); }
}
typedef short s16x2_t __attribute__((ext_vector_type(2)));
__device__ __forceinline__ unsigned fp8x4_scaled(float a, float b, float c, float d, float scale) {
    s16x2_t w = {0, 0}; w = __builtin_amdgcn_cvt_scalef32_pk_fp8_f32(w, a, b, scale, false); w = __builtin_amdgcn_cvt_scalef32_pk_fp8_f32(w, c, d, scale, true); return __builtin_bit_cast(unsigned, w); }
#define LDS_WAIT() asm volatile("s_waitcnt lgkmcnt(0)" ::: "memory")
#define VM_WAIT() asm volatile("s_waitcnt vmcnt(0)" ::: "memory")

namespace pg8 {
constexpr int BM = 256, BK = 64, HALF = 128, HTB = HALF * BK * 2, STAGE_BYTES = 8 * HTB, NXCD = 8, WGM = 8;
__host__ __device__ __forceinline__ int lds_byte(int r, int c) { const int st = (r >> 4) * 2 + (c >> 5), rr = r & 15, cc = c & 31, ob = rr * 64 + cc * 2; return st * 1024 + (ob ^ (((ob >> 9) & 1) << 5)); }
__host__ __device__ __forceinline__ void stage_rc(int b, int& R, int& C) { const int st = b / 1024, sb = b % 1024, swz = sb ^ (((sb >> 9) & 1) << 5); R = (st >> 1) * 16 + swz / 64; C = (st & 1) * 32 + (swz % 64) / 2; }
__host__ __device__ __forceinline__ int perm32(int rho) { const int n = rho >> 4, i = rho & 15; return 8 * (i >> 2) + 4 * n + (i & 3); }

struct Unit { int pm, pn, aux; };
struct Dims { int lda, ldb, K; };

struct NoCtx {};
template <class Epi> __device__ __forceinline__ auto epi_prep(const Epi& E, const Unit& u, int wr, int cg, int fr, int) -> decltype(E.prep(u, wr, cg, fr)) { return E.prep(u, wr, cg, fr); }
template <class Epi> __device__ __forceinline__ NoCtx epi_prep(const Epi&, const Unit&, int, int, int, long) { return NoCtx{}; }
template <class Epi, class C> __device__ __forceinline__ auto epi_store(const Epi& E, const Unit& u, int r, int cg, const float (&a)[8], const float (&b)[8], const C& c, int i, int) -> decltype(E.store8(u, r, cg, a, b, c, i)) { E.store8(u, r, cg, a, b, c, i); }
template <class Epi, class C> __device__ __forceinline__ void epi_store(const Epi& E, const Unit& u, int r, int cg, const float (&a)[8], const float (&b)[8], const C&, int, long) { E.store8(u, r, cg, a, b); }
template <class Epi>
__device__ __forceinline__ void epi_run(const Epi& E, const f32x4 (&acc)[2][2][4][2], const Unit& u, int wr, int wc, int fr, int fq) {
    asm volatile("" : "+v"(fr), "+v"(fq));
    const int cg = 4 * wc + fq;
    const auto ctx = epi_prep(E, u, wr, cg, fr, 0);
    if constexpr (Epi::PAIR) {
#pragma unroll
        for (int ai = 0; ai < 2; ++ai)
#pragma unroll
            for (int mp = 0; mp < 2; ++mp) {
                const int r = ai * HALF + wr * 64 + mp * 32 + fr;
                float a0[8], b0[8], a1[8], b1[8];
#pragma unroll
                for (int j = 0; j < 4; ++j) { a0[j] = acc[ai][0][2 * mp][0][j]; a0[4 + j] = acc[ai][0][2 * mp][1][j]; b0[j] = acc[ai][1][2 * mp][0][j]; b0[4 + j] = acc[ai][1][2 * mp][1][j];
                    a1[j] = acc[ai][0][2 * mp + 1][0][j]; a1[4 + j] = acc[ai][0][2 * mp + 1][1][j]; b1[j] = acc[ai][1][2 * mp + 1][0][j]; b1[4 + j] = acc[ai][1][2 * mp + 1][1][j]; }
                E.store_pair(u, r, cg, a0, b0, a1, b1, ctx, ai * 4 + 2 * mp);
            }
    } else {
#pragma unroll
    for (int ai = 0; ai < 2; ++ai)
#pragma unroll
        for (int m = 0; m < 4; ++m) {
            const int r = ai * HALF + wr * 64 + m * 16 + fr;
            float a[8], b[8];
#pragma unroll
            for (int j = 0; j < 4; ++j) { a[j] = acc[ai][0][m][0][j]; a[4 + j] = acc[ai][0][m][1][j]; b[j] = acc[ai][1][m][0][j]; b[4 + j] = acc[ai][1][m][1][j]; }
            epi_store(E, u, r, cg, a, b, ctx, ai * 4 + m, 0);
        }
    }
}
__device__ __forceinline__ u32x4 pair_swap(const u32x2 o0, const u32x2 o1) {
    const auto X = __builtin_amdgcn_permlane16_swap(o0.x, o1.x, false, false); const auto Y = __builtin_amdgcn_permlane16_swap(o0.y, o1.y, false, false);
    return (u32x4){X[0], Y[0], X[1], Y[1]};
}

template <class Epi, class Sched, bool GATHER>
__device__ __forceinline__ void gemm_phase(LAS unsigned char* lds, const Dims g, const Sched& S, const Epi& E) {
    const int tid = threadIdx.x, wid = __builtin_amdgcn_readfirstlane(tid >> 6), lane = tid & 63, wr = wid >> 2, wc = wid & 3, fr = lane & 15, fq = lane >> 4;
    const int K = g.K, nt = K / BK;
    int Rr[2]; unsigned cofs[2], voffB[2];
#pragma unroll
    for (int i = 0; i < 2; ++i) { int R, C; stage_rc(tid * 16 + i * 8192, R, C); const int Rb = (R & ~31) + perm32(R & 31);
        Rr[i] = R; cofs[i] = (unsigned)C * 2u; voffB[i] = (unsigned)(Rb * g.ldb + C) * 2u; }
    const size_t kstep = (size_t)(BK * 2);
    const size_t hstepB = (size_t)HALF * g.ldb * 2;
    const unsigned ldsw = (unsigned)wid * 1024u;
    const int aoff = lds_byte(wr * 64 + fr, fq * 8), boff = lds_byte(wc * 32 + fr, fq * 8);
    const unsigned ldab = (unsigned)g.lda * 2u;
#define PG8_SA(b, h) (((b) * 2 + (h)) * HTB)
#define PG8_SB(b, h) ((4 + (b) * 2 + (h)) * HTB)
#define PG8_STB(bufoff, gbase) do { _Pragma("unroll") for (int _i = 0; _i < 2; ++_i) \
        __builtin_amdgcn_global_load_lds((const unsigned*)((const char*)(gbase) + voffB[_i]), (LAS unsigned*)(lds + (bufoff) + ldsw + _i * 8192), 16, 0, 0); } while (0)
#define PG8_STA(bufoff, gbase, V, h) do { _Pragma("unroll") for (int _i = 0; _i < 2; ++_i) \
        __builtin_amdgcn_global_load_lds((const unsigned*)((const char*)(gbase) + (V)[h][_i]), (LAS unsigned*)(lds + (bufoff) + ldsw + _i * 8192), 16, 0, 0); } while (0)
#define PG8_LDV(u_, V) do { if constexpr (GATHER) { const int* rw_ = S.rows(u_); \
        _Pragma("unroll") for (int h_ = 0; h_ < 2; ++h_) _Pragma("unroll") for (int i_ = 0; i_ < 2; ++i_) (V)[h_][i_] = (unsigned)rw_[h_ * HALF + Rr[i_]] * ldab + cofs[i_]; } \
        else { _Pragma("unroll") for (int h_ = 0; h_ < 2; ++h_) _Pragma("unroll") for (int i_ = 0; i_ < 2; ++i_) (V)[h_][i_] = (unsigned)(h_ * HALF + Rr[i_]) * ldab + cofs[i_]; } } while (0)
#define PG8_LDA(dst, b, h) do { _Pragma("unroll") for (int m = 0; m < 4; ++m) _Pragma("unroll") for (int k = 0; k < 2; ++k) dst[m][k] = *(const LAS bf16x8*)(lds + PG8_SA(b, h) + aoff + m * 2048 + k * 1024); } while (0)
#define PG8_LDB(dst, b, h) do { _Pragma("unroll") for (int n = 0; n < 2; ++n) _Pragma("unroll") for (int k = 0; k < 2; ++k) dst[n][k] = *(const LAS bf16x8*)(lds + PG8_SB(b, h) + boff + n * 2048 + k * 1024); } while (0)
#define PG8_MMA(ai, bj, At, Bt) do { __builtin_amdgcn_s_setprio(1); _Pragma("unroll") for (int m = 0; m < 4; ++m) _Pragma("unroll") for (int n = 0; n < 2; ++n) _Pragma("unroll") for (int k = 0; k < 2; ++k) \
        acc[ai][bj][m][n] = __builtin_amdgcn_mfma_f32_16x16x32_bf16(Bt[n][k], At[m][k], acc[ai][bj][m][n], 0, 0, 0); __builtin_amdgcn_s_setprio(0); } while (0)
#define PG8_WAIT_V(n) asm volatile("s_waitcnt vmcnt(" #n ")" ::: "memory")
#define PG8_WAIT_L(n) asm volatile("s_waitcnt lgkmcnt(" #n ")" ::: "memory")
#define PG8_BAR __builtin_amdgcn_s_barrier()
#define PG8_SCHED __builtin_amdgcn_sched_barrier(0)
    Unit cur, nxt; int ui = 0;
    if (!S.next(0, cur)) return;
    f32x4 acc[2][2][4][2];
#pragma unroll
    for (int a = 0; a < 2; ++a)
#pragma unroll
        for (int b = 0; b < 2; ++b)
#pragma unroll
            for (int m = 0; m < 4; ++m)
#pragma unroll
                for (int n = 0; n < 2; ++n) acc[a][b][m][n] = (f32x4){0.f, 0.f, 0.f, 0.f};
    bf16x8 At[4][2], B0[2][2], B1[2][2];
    unsigned vAc[2][2], vAn[2][2];
    const char* cA = S.abase(cur); const char* cB = S.bbase(cur);
    PG8_LDV(cur, vAc);
    PG8_STB(PG8_SB(0, 0), cB); PG8_STB(PG8_SB(0, 1), cB + hstepB); PG8_STA(PG8_SA(0, 0), cA, vAc, 0); PG8_STA(PG8_SA(0, 1), cA, vAc, 1);
    if (wr == 1) PG8_BAR;
    PG8_WAIT_V(2); PG8_BAR;
    PG8_STB(PG8_SB(1, 0), cB + kstep); PG8_STA(PG8_SA(1, 0), cA + kstep, vAc, 0); PG8_STB(PG8_SB(1, 1), cB + hstepB + kstep);
    PG8_WAIT_V(6); PG8_BAR;
    for (;;) {
        const bool has_next = S.next(ui + 1, nxt);
        const char* nA = has_next ? S.abase(nxt) : cA; const char* nB = has_next ? S.bbase(nxt) : cB;
        if (has_next) { PG8_LDV(nxt, vAn); }
        else {
#pragma unroll
            for (int h = 0; h < 2; ++h)
#pragma unroll
                for (int i = 0; i < 2; ++i) vAn[h][i] = vAc[h][i];
        }
        for (int t = 0; t < nt; t += 2) {
            const bool last = (t == nt - 2);
            const char* a1 = cA + (size_t)(t + 1) * kstep;
            const char* a2 = last ? nA : cA + (size_t)(t + 2) * kstep; const char* b2 = last ? nB : cB + (size_t)(t + 2) * kstep;
            const char* a3 = a2 + kstep; const char* b3 = b2 + kstep;
            unsigned v2[2][2];
#pragma unroll
            for (int h = 0; h < 2; ++h)
#pragma unroll
                for (int i = 0; i < 2; ++i) v2[h][i] = last ? vAn[h][i] : vAc[h][i];
            PG8_LDB(B0, 0, 0); PG8_LDB(B1, 0, 1); PG8_SCHED; PG8_LDA(At, 0, 0); PG8_STA(PG8_SA(1, 1), a1, vAc, 1);
            PG8_WAIT_V(8); PG8_WAIT_L(0); PG8_BAR; PG8_MMA(0, 0, At, B0); PG8_MMA(0, 1, At, B1); PG8_BAR; PG8_SCHED;
            PG8_LDA(At, 0, 1); PG8_STB(PG8_SB(0, 0), b2); PG8_STB(PG8_SB(0, 1), b2 + hstepB); PG8_STA(PG8_SA(0, 0), a2, v2, 0);
            PG8_WAIT_V(8); PG8_WAIT_L(0); PG8_BAR; PG8_MMA(1, 0, At, B0); PG8_MMA(1, 1, At, B1); PG8_BAR; PG8_SCHED;
            PG8_LDB(B0, 1, 0); PG8_LDB(B1, 1, 1); PG8_SCHED; PG8_LDA(At, 1, 0); PG8_STA(PG8_SA(0, 1), a2, v2, 1);
            PG8_WAIT_V(8); PG8_WAIT_L(0); PG8_BAR; PG8_MMA(0, 0, At, B0); PG8_MMA(0, 1, At, B1); PG8_BAR; PG8_SCHED;
            PG8_LDA(At, 1, 1); PG8_STB(PG8_SB(1, 0), b3); PG8_STB(PG8_SB(1, 1), b3 + hstepB); PG8_STA(PG8_SA(1, 0), a3, v2, 0);
            PG8_WAIT_V(8); PG8_WAIT_L(0); PG8_BAR; PG8_MMA(1, 0, At, B0); PG8_MMA(1, 1, At, B1); PG8_BAR; PG8_SCHED;
        }
        if (wr == 0) PG8_BAR;
        epi_run(E, acc, cur, wr, wc, fr, fq);
        if (!has_next) break;
#pragma unroll
        for (int a = 0; a < 2; ++a)
#pragma unroll
            for (int b = 0; b < 2; ++b)
#pragma unroll
                for (int m = 0; m < 4; ++m)
#pragma unroll
                    for (int n = 0; n < 2; ++n) acc[a][b][m][n] = (f32x4){0.f, 0.f, 0.f, 0.f};
        cur = nxt; cA = nA; cB = nB; ++ui;
#pragma unroll
        for (int h = 0; h < 2; ++h)
#pragma unroll
            for (int i = 0; i < 2; ++i) vAc[h][i] = vAn[h][i];
        if (wr == 1) PG8_BAR;
    }
    PG8_WAIT_V(0);
    PG8_BAR;
#undef PG8_SA
#undef PG8_SB
#undef PG8_STB
#undef PG8_STA
#undef PG8_LDV
#undef PG8_LDA
#undef PG8_LDB
#undef PG8_MMA
#undef PG8_WAIT_V
#undef PG8_WAIT_L
#undef PG8_BAR
#undef PG8_SCHED
}

__device__ __forceinline__ void glds16_s(const void* sbase, unsigned voff, unsigned lds_dst) { unsigned keep;
    asm volatile("s_mov_b32 %0, m0\n\ts_mov_b32 m0, %3\n\ts_nop 0\n\tglobal_load_lds_dwordx4 %1, %2\n\ts_mov_b32 m0, %0" : "=&s"(keep) : "v"(voff), "s"(sbase), "s"(lds_dst) : "memory"); }
__device__ __forceinline__ void glds4_s(const void* sbase, unsigned voff, unsigned lds_dst) { unsigned keep;
    asm volatile("s_mov_b32 %0, m0\n\ts_mov_b32 m0, %3\n\ts_nop 0\n\tglobal_load_lds_dword %1, %2\n\ts_mov_b32 m0, %0" : "=&s"(keep) : "v"(voff), "s"(sbase), "s"(lds_dst) : "memory"); }
typedef int i32x4 __attribute__((ext_vector_type(4)));
typedef int i32x8 __attribute__((ext_vector_type(8)));
constexpr int SCL_OFF = STAGE_BYTES;
template <class Epi, class Sched, bool GATHER>
__device__ __forceinline__ void gemm_phase_mx(LAS unsigned char* lds, const Dims g, const Sched& S, const Epi& E) {
    const int tid = threadIdx.x, wid = __builtin_amdgcn_readfirstlane(tid >> 6), lane = tid & 63, wr = wid >> 2, wc = wid & 3, fr = lane & 15, fq = lane >> 4;
    const int K = g.K, nt = K / BK;
    unsigned voffB[2];
#pragma unroll
    for (int i = 0; i < 2; ++i) { int R, C; stage_rc(tid * 16 + i * 8192, R, C); const int Rb = (R & ~31) + perm32(R & 31); voffB[i] = (unsigned)(Rb * g.ldb + C) * 2u; }
    const size_t kstep = (size_t)(BK * 2);
    const size_t hstepB = (size_t)HALF * g.ldb * 2;
    const unsigned ldsw = (unsigned)wid * 1024u, ldsb = (unsigned)(unsigned long)lds;
    const int aoff = lds_byte(wr * 64 + fr, fq * 8), boff = lds_byte(wc * 32 + fr, fq * 8);
    const unsigned ldab = (unsigned)g.lda * 2u;
    const int si_ = (wid & 3) * 64 + lane;
    const int srow = ((si_ >> 2) & 1) * 128 + (si_ >> 7) * 64 + (si_ & 3) * 16 + ((si_ >> 3) & 15);
    const int sslot = ((si_ >> 1) & 1) * 128 + (si_ >> 6) * 32 + (si_ & 1) * 16 + ((si_ >> 2) & 15);
    const int sBrow = (sslot & 128) + ((sslot & 127) & ~31) + perm32(sslot & 31);
    const unsigned sldst = (unsigned)(SCL_OFF + (wid >> 2) * 1024 + (wid & 3) * 256);
    unsigned a_rd = ldsb + (unsigned)aoff, b_rd = ldsb + (unsigned)(boff + 4 * HTB), sa_rd = ldsb + (unsigned)(SCL_OFF + (wr * 16 + fr) * 32), sb_rd = ldsb + (unsigned)(SCL_OFF + 1024 + (wc * 16 + fr) * 16);
    int ssh = fq * 8;
    asm volatile("" : "+v"(a_rd), "+v"(b_rd), "+v"(sa_rd), "+v"(sb_rd), "+v"(ssh));
#define PG8_SA(b, h) (((b) * 2 + (h)) * HTB)
#define PG8_SB(b, h) ((4 + (b) * 2 + (h)) * HTB)
#define PG8_STB(bufoff, gbase) do { _Pragma("unroll") for (int _i = 0; _i < 2; ++_i) glds16_s((gbase), voffB[_i], ldsb + (unsigned)((bufoff) + _i * 8192) + ldsw); } while (0)
#define PG8_STA(bufoff, gbase, V, h) do { _Pragma("unroll") for (int _i = 0; _i < 2; ++_i) glds16_s((gbase), (V)[h][_i], ldsb + (unsigned)((bufoff) + _i * 8192) + ldsw); } while (0)
#define PG8_STS(b, sp, so) glds4_s((sp), (so), ldsb + sldst + (unsigned)((b) * 2048))
#define PG8_LDV(u_, V) do { int tl_ = tid; asm volatile("" : "+v"(tl_)); const int* rw_ = GATHER ? S.rows(u_) : nullptr; \
        _Pragma("unroll") for (int i_ = 0; i_ < 2; ++i_) { int R_, C_; stage_rc(tl_ * 16 + i_ * 8192, R_, C_); \
        _Pragma("unroll") for (int h_ = 0; h_ < 2; ++h_) (V)[h_][i_] = (unsigned)(GATHER ? rw_[h_ * HALF + R_] : (h_ * HALF + R_)) * ldab + (unsigned)C_ * 2u; } } while (0)
#define PG8_SBASE(u_) ((wid < 4) ? (const char*)S.sa_base(u_) : (const char*)S.sb_base(u_))
#define PG8_SOFF(u_) ((unsigned)((wid < 4) ? (GATHER ? S.rows(u_)[srow] : srow) : sBrow) * (unsigned)(nt * 4))
#define PG8_LDA(dst, b, h) do { _Pragma("unroll") for (int m = 0; m < 4; ++m) _Pragma("unroll") for (int k = 0; k < 2; ++k) dst[m][k] = *(const LAS i32x4*)(unsigned long)(a_rd + (unsigned)(PG8_SA(b, h) + m * 2048 + k * 1024)); } while (0)
#define PG8_LDB(dst, b, h) do { _Pragma("unroll") for (int n = 0; n < 2; ++n) _Pragma("unroll") for (int k = 0; k < 2; ++k) dst[n][k] = *(const LAS i32x4*)(unsigned long)(b_rd + (unsigned)(((b) * 2 + (h)) * HTB + n * 2048 + k * 1024)); } while (0)
#define PG8_U8(off) ((unsigned)*(const LAS unsigned char*)(unsigned long)(off))
#define PG8_LDSC(b) do { const i32x4 a0_ = *(const LAS i32x4*)(unsigned long)(sa_rd + (unsigned)((b) * 2048)), a1_ = *(const LAS i32x4*)(unsigned long)(sa_rd + (unsigned)((b) * 2048 + 16)), \
        b0_ = *(const LAS i32x4*)(unsigned long)(sb_rd + (unsigned)((b) * 2048)); \
        _Pragma("unroll") for (int q_ = 0; q_ < 4; ++q_) { scA[q_] = a0_[q_]; scA[4 + q_] = a1_[q_]; scB[q_] = b0_[q_]; } } while (0)
#define PG8_SCSH do { _Pragma("unroll") for (int q_ = 0; q_ < 8; ++q_) scA[q_] = (int)((unsigned)scA[q_] >> ssh); _Pragma("unroll") for (int q_ = 0; q_ < 4; ++q_) scB[q_] = (int)((unsigned)scB[q_] >> ssh); } while (0)
#define PG8_CAT(x) (i32x8){x[0][0], x[0][1], x[0][2], x[0][3], x[1][0], x[1][1], x[1][2], x[1][3]}
#define PG8_MM1(ai, bj, m, n, At, Bt) acc[ai][bj][m][n] = __builtin_amdgcn_mfma_scale_f32_16x16x128_f8f6f4(PG8_CAT(Bt[n]), PG8_CAT(At[m]), acc[ai][bj][m][n], 0, 0, 0, scB[(bj) * 2 + (n)], 0, scA[(ai) * 4 + (m)])
#define PG8_MMA(ai, bj, At, Bt) do { __builtin_amdgcn_s_setprio(1); PG8_MM1(ai, bj, 0, 0, At, Bt); PG8_MM1(ai, bj, 0, 1, At, Bt); PG8_MM1(ai, bj, 1, 0, At, Bt); PG8_MM1(ai, bj, 1, 1, At, Bt); \
        PG8_MM1(ai, bj, 2, 0, At, Bt); PG8_MM1(ai, bj, 2, 1, At, Bt); PG8_MM1(ai, bj, 3, 0, At, Bt); PG8_MM1(ai, bj, 3, 1, At, Bt); __builtin_amdgcn_s_setprio(0); } while (0)
#define PG8_WAIT_V(n) asm volatile("s_waitcnt vmcnt(" #n ")" ::: "memory")
#define PG8_WAIT_L(n) asm volatile("s_waitcnt lgkmcnt(" #n ")" ::: "memory")
#define PG8_BAR __builtin_amdgcn_s_barrier()
#define PG8_SCHED __builtin_amdgcn_sched_barrier(0)
    Unit cur, nxt; int ui = 0;
    if (!S.next(0, cur)) return;
    f32x4 acc[2][2][4][2];
#pragma unroll
    for (int a = 0; a < 2; ++a)
#pragma unroll
        for (int b = 0; b < 2; ++b)
#pragma unroll
            for (int m = 0; m < 4; ++m)
#pragma unroll
                for (int n = 0; n < 2; ++n) acc[a][b][m][n] = (f32x4){0.f, 0.f, 0.f, 0.f};
    i32x4 At[4][2], B0[2][2], B1[2][2]; int scA[8], scB[4];
    unsigned vAc[2][2], vAn[2][2];
    const char* cA = S.abase(cur); const char* cB = S.bbase(cur);
    const char* sBc = PG8_SBASE(cur); const char* sBn = sBc; unsigned sOc = PG8_SOFF(cur), sOn = sOc;
    PG8_LDV(cur, vAc);
    PG8_STS(0, sBc, sOc);
    PG8_STB(PG8_SB(0, 0), cB); PG8_STB(PG8_SB(0, 1), cB + hstepB); PG8_STA(PG8_SA(0, 0), cA, vAc, 0); PG8_STA(PG8_SA(0, 1), cA, vAc, 1);
    if (wr == 1) PG8_BAR;
    PG8_WAIT_V(2); PG8_BAR;
    PG8_STS(1, sBc + 4, sOc);
    PG8_STB(PG8_SB(1, 0), cB + kstep); PG8_STA(PG8_SA(1, 0), cA + kstep, vAc, 0); PG8_STB(PG8_SB(1, 1), cB + hstepB + kstep);
    PG8_WAIT_V(6); PG8_BAR;
    for (;;) {
        const bool has_next = S.next(ui + 1, nxt);
        const char* nA = has_next ? S.abase(nxt) : cA; const char* nB = has_next ? S.bbase(nxt) : cB;
        if (has_next) { PG8_LDV(nxt, vAn); sBn = PG8_SBASE(nxt); sOn = PG8_SOFF(nxt); }
        else { sBn = sBc; sOn = sOc;
#pragma unroll
            for (int h = 0; h < 2; ++h)
#pragma unroll
                for (int i = 0; i < 2; ++i) vAn[h][i] = vAc[h][i];
        }
        for (int t = 0; t < nt; t += 2) {
            const bool last = (t == nt - 2);
            const char* a1 = cA + (size_t)(t + 1) * kstep;
            const char* a2 = last ? nA : cA + (size_t)(t + 2) * kstep; const char* b2 = last ? nB : cB + (size_t)(t + 2) * kstep;
            const char* a3 = a2 + kstep; const char* b3 = b2 + kstep;
            const char* s2 = last ? sBn : sBc + (size_t)(t + 2) * 4;
            PG8_LDB(B0, 0, 0); PG8_LDB(B1, 0, 1); PG8_LDSC(0); PG8_SCHED; PG8_LDA(At, 0, 0); PG8_STA(PG8_SA(1, 1), a1, vAc, 1);
            if (last) { sOc = sOn;
#pragma unroll
                for (int h = 0; h < 2; ++h)
#pragma unroll
                    for (int i = 0; i < 2; ++i) vAc[h][i] = vAn[h][i]; }
            PG8_WAIT_V(9); PG8_WAIT_L(0); PG8_BAR; PG8_SCSH; PG8_MMA(0, 0, At, B0); PG8_MMA(0, 1, At, B1); PG8_BAR; PG8_SCHED;
            PG8_LDA(At, 0, 1); PG8_STB(PG8_SB(0, 0), b2); PG8_STB(PG8_SB(0, 1), b2 + hstepB); PG8_STA(PG8_SA(0, 0), a2, vAc, 0); PG8_STS(0, s2, sOc);
            PG8_WAIT_V(9); PG8_WAIT_L(0); PG8_BAR; PG8_MMA(1, 0, At, B0); PG8_MMA(1, 1, At, B1); PG8_BAR; PG8_SCHED;
            PG8_LDB(B0, 1, 0); PG8_LDB(B1, 1, 1); PG8_LDSC(1); PG8_SCHED; PG8_LDA(At, 1, 0); PG8_STA(PG8_SA(0, 1), a2, vAc, 1);
            PG8_WAIT_V(9); PG8_WAIT_L(0); PG8_BAR; PG8_SCSH; PG8_MMA(0, 0, At, B0); PG8_MMA(0, 1, At, B1); PG8_BAR; PG8_SCHED;
            PG8_LDA(At, 1, 1); PG8_STB(PG8_SB(1, 0), b3); PG8_STB(PG8_SB(1, 1), b3 + hstepB); PG8_STA(PG8_SA(1, 0), a3, vAc, 0); PG8_STS(1, s2 + 4, sOc);
            PG8_WAIT_V(9); PG8_WAIT_L(0); PG8_BAR; PG8_MMA(1, 0, At, B0); PG8_MMA(1, 1, At, B1); PG8_BAR; PG8_SCHED;
        }
        if (wr == 0) PG8_BAR;
        epi_run(E, acc, cur, wr, wc, fr, fq);
        if (!has_next) break;
#pragma unroll
        for (int a = 0; a < 2; ++a)
#pragma unroll
            for (int b = 0; b < 2; ++b)
#pragma unroll
                for (int m = 0; m < 4; ++m)
#pragma unroll
                    for (int n = 0; n < 2; ++n) acc[a][b][m][n] = (f32x4){0.f, 0.f, 0.f, 0.f};
        cur = nxt; cA = nA; cB = nB; sBc = sBn; sOc = sOn; ++ui;
#pragma unroll
        for (int h = 0; h < 2; ++h)
#pragma unroll
            for (int i = 0; i < 2; ++i) vAc[h][i] = vAn[h][i];
        if (wr == 1) PG8_BAR;
    }
    PG8_WAIT_V(0);
    PG8_BAR;
#undef PG8_SA
#undef PG8_SB
#undef PG8_STB
#undef PG8_STA
#undef PG8_STS
#undef PG8_LDV
#undef PG8_SBASE
#undef PG8_SOFF
#undef PG8_LDA
#undef PG8_LDB
#undef PG8_LDSC
#undef PG8_SCSH
#undef PG8_U8
#undef PG8_MM1
#undef PG8_CAT
#undef PG8_MMA
#undef PG8_WAIT_V
#undef PG8_WAIT_L
#undef PG8_BAR
#undef PG8_SCHED
}

template <class Epi, class Sched, bool GATHER>
__device__ __forceinline__ void gemm_naive(const Dims g, const Sched& S, const Epi& E) {
    Unit u;
    for (int i = 0; S.next(i, u); ++i) {
        const char* aB = S.abase(u); const char* bB = S.bbase(u);
        for (int item = threadIdx.x; item < 4096; item += NTHREADS) {
            const int r = item >> 4, cg = item & 15;
            const char* arow;
            if constexpr (GATHER) arow = aB + (size_t)S.rows(u)[r] * g.lda * 2; else arow = aB + (size_t)r * g.lda * 2;
            float a[8], b[8];
#pragma unroll
            for (int j = 0; j < 8; ++j) { a[j] = 0.f; b[j] = 0.f; }
            for (int k8 = 0; k8 < g.K / 8; ++k8) {
                float av[8]; ld8bf((const bf16_t*)(arow + k8 * 16), av);
#pragma unroll
                for (int j = 0; j < 8; ++j) {
                    float bv[8]; ld8bf((const bf16_t*)(bB + (size_t)(cg * 8 + j) * g.ldb * 2 + k8 * 16), bv);
                    float s = 0.f;
#pragma unroll
                    for (int q = 0; q < 8; ++q) s += av[q] * bv[q];
                    a[j] += s;
                    ld8bf((const bf16_t*)(bB + (size_t)(128 + cg * 8 + j) * g.ldb * 2 + k8 * 16), bv);
                    s = 0.f;
#pragma unroll
                    for (int q = 0; q < 8; ++q) s += av[q] * bv[q];
                    b[j] += s;
                }
            }
            E.store8(u, r, cg, a, b);
        }
    }
}

template <class Epi, class Sched, bool GATHER>
__device__ __forceinline__ void gemm_run(LAS unsigned char* lds, const Dims g, const Sched& S, const Epi& E) {
#if NAIVE_GEMM
    gemm_naive<Epi, Sched, GATHER>(g, S, E);
#else
    gemm_phase<Epi, Sched, GATHER>(lds, g, S, E);
#endif
}

struct RegOrder {
    const char* A; const char* Bt; int lda, ldb; int nM, nN, nwg, G, c;
    __device__ __forceinline__ void init(const void* A_, const void* Bt_, int lda_, int ldb_, int M, int N, int G_, int c_) { A = (const char*)A_; Bt = (const char*)Bt_; lda = lda_; ldb = ldb_; nM = M / BM; nN = N / BM; nwg = nM * nN; G = G_; c = c_; }
    __device__ __forceinline__ bool next(int i, Unit& u) const {
        const long L = (long)i * G + c; if (L >= nwg) return false;
        int wgid = (int)L; { const int q = nwg / NXCD, r = nwg % NXCD, xcd = wgid % NXCD, off = wgid / NXCD; wgid = (xcd < r ? xcd * (q + 1) : r * (q + 1) + (xcd - r) * q) + off; }
        const int nig = WGM * nN, gid = wgid / nig, fm = gid * WGM, gsz = (nM - fm) < WGM ? (nM - fm) : WGM;
        u.pm = fm + ((wgid % nig) % gsz); u.pn = (wgid % nig) / gsz; u.aux = 0; return true;
    }
    __device__ __forceinline__ const char* abase(const Unit& u) const { return A + (size_t)u.pm * BM * lda * 2; }
    __device__ __forceinline__ const char* bbase(const Unit& u) const { return Bt + (size_t)u.pn * BM * ldb * 2; }
    __device__ __forceinline__ const int* rows(const Unit&) const { return nullptr; }
};
struct RegOrderMx : RegOrder {
    const unsigned* sA; const unsigned* sB; int nt;
    __device__ __forceinline__ const unsigned* sa_base(const Unit& u) const { return sA + (size_t)u.pm * BM * nt; }
    __device__ __forceinline__ const unsigned* sb_base(const Unit& u) const { return sB + (size_t)u.pn * BM * nt; }
};
struct SsmOrder {
    const char* A; const char* Bt; int nPN, ldb, nrowsB, G, c;
    __device__ __forceinline__ bool next(int i, Unit& u) const {
        const int L = i * G + c; if (L >= NGRP * 2 * nPN) return false;
        u.aux = L / (2 * nPN); const int r = L % (2 * nPN); u.pm = r / nPN; u.pn = r % nPN; return true;
    }
    __device__ __forceinline__ const char* abase(const Unit& u) const { return A + ((size_t)u.aux * GROWS + (size_t)u.pm * BM) * UEXT_LD * 2; }
    __device__ __forceinline__ const char* bbase(const Unit& u) const { return Bt + ((size_t)u.aux * nrowsB + (size_t)u.pn * BM) * ldb * 2; }
    __device__ __forceinline__ const int* rows(const Unit&) const { return nullptr; }
};
struct MoeOrder {
    const char* A; const char* Bt; const int* slot_tok; const LAS int* tstart; int nN, ldb, nrowsB, lda, G, c;
    __device__ __forceinline__ bool next(int i, Unit& u) const {
        const int NT = tstart[NEXP]; const int L = i * G + c; if (L >= NT * nN) return false;
        const int tile = L / nN; u.pn = L % nN; u.pm = tile; int e = 0;
#pragma unroll
        for (int k = 1; k < NEXP; ++k) e += (tstart[k] <= tile) ? 1 : 0;
        u.aux = __builtin_amdgcn_readfirstlane(e); return true;
    }
    __device__ __forceinline__ const char* abase(const Unit& u) const { return lists ? A + ((size_t)u.aux * 16384 + (size_t)(u.pm - tstart[u.aux]) * BM) * lda * 2 : (slot_tok ? A : A + (size_t)u.pm * BM * lda * 2); }
    __device__ __forceinline__ const char* bbase(const Unit& u) const { return Bt + ((size_t)u.aux * nrowsB + (size_t)u.pn * BM) * ldb * 2; }
    __device__ __forceinline__ const int* rows(const Unit& u) const { return slot_tok + (size_t)u.pm * BM; }
    const unsigned* sA; const unsigned* sB; int nt; int lists;
    __device__ __forceinline__ const unsigned* sa_base(const Unit& u) const { return lists ? sA + ((size_t)u.aux * 16384 + (size_t)(u.pm - tstart[u.aux]) * BM) * nt : (slot_tok ? sA : sA + (size_t)u.pm * BM * nt); }
    __device__ __forceinline__ const unsigned* sb_base(const Unit& u) const { return sB + ((size_t)u.aux * nrowsB + (size_t)u.pn * BM) * nt; }
};
}

using pg8::Unit;
struct EpiInProj { static constexpr bool PAIR = false; bf16_t *uext, *q, *k, *v, *gs, *ga;
    __device__ __forceinline__ void one(const Unit& u, int m, int c, const float (&x)[8]) const {
        const int reg = u.pn >> 2; const int bb = m >> 13, t = m & 8191;
        if (reg == 0) { const int g = c >> 4, hf = (c >> 3) & 1; st8bf(uext + ((size_t)(g * GROWS + bb * NCHUNK + (t >> 5)) * UEXT_LD + (t & 31) * 16 + hf * 8), x); }
        else if (reg == 1) { float y[8];
#pragma unroll
            for (int j = 0; j < 8; ++j) y[j] = x[j] * QSCALE;
            st8bf(q + (size_t)m * 1024 + (c - 1024), y); }
        else if (reg == 2) st8bf(k + (size_t)m * 1024 + (c - 2048), x);
        else if (reg == 3) st8bf(v + (size_t)m * 1024 + (c - 3072), x);
        else { float y[8];
#pragma unroll
            for (int j = 0; j < 8; ++j) y[j] = sigmoidf_fast(x[j]);
            if (reg < 6) st8bf(gs + (size_t)m * 2048 + (c - 4096), y); else st8bf(ga + (size_t)m * 2048 + (c - 6144), y); }
    }
    __device__ __forceinline__ void store8(const Unit& u, int r, int cg, const float (&a)[8], const float (&b)[8]) const {
        const int m = u.pm * 256 + r, c = u.pn * 256 + cg * 8; one(u, m, c, a); one(u, m, c + 128, b);
    }
};
struct EpiGates { static constexpr bool PAIR = false; bf16_t *gs, *ga;
    __device__ __forceinline__ void one(int m, int c, const float (&x)[8]) const { float y[8];
#pragma unroll
        for (int j = 0; j < 8; ++j) y[j] = sigmoidf_fast(x[j]);
        if (c < 2048) st8bf(gs + (size_t)m * 2048 + c, y); else st8bf(ga + (size_t)m * 2048 + (c - 2048), y); }
    __device__ __forceinline__ void store8(const Unit& u, int r, int cg, const float (&a)[8], const float (&b)[8]) const { const int m = u.pm * 256 + r, c = u.pn * 256 + cg * 8; one(m, c, a); one(m, c + 128, b); }
};
struct EpiS1 { static constexpr bool PAIR = false; float* S;
    __device__ __forceinline__ void store8(const Unit& u, int r, int cg, const float (&a)[8], const float (&b)[8]) const {
        float* p = S + ((size_t)(u.aux * GROWS + u.pm * 256 + r) * 256 + cg * 8);
        *(f32x4*)p = (f32x4){a[0], a[1], a[2], a[3]}; *(f32x4*)(p + 4) = (f32x4){a[4], a[5], a[6], a[7]};
        *(f32x4*)(p + 128) = (f32x4){b[0], b[1], b[2], b[3]}; *(f32x4*)(p + 132) = (f32x4){b[4], b[5], b[6], b[7]};
    }
};
__device__ __forceinline__ float gelu_tanh(float x) { const float z = 0.7978845608028654f * (x + 0.044715f * x * x * x); return x * __builtin_amdgcn_rcpf(1.0f + __builtin_amdgcn_exp2f(-2.0f * LOG2E * z)); }
struct EpiS3 { static constexpr bool PAIR = false; bf16_t* y;
    __device__ __forceinline__ void one(const Unit& u, int row, int col, const float (&x)[8]) const {
        const int bb = row >> 8, c = row & 255, tau = col >> 4, o8 = col & 15; const int m = bb * SEQ + c * CHUNK + tau; float z[8];
#pragma unroll
        for (int j = 0; j < 8; ++j) z[j] = gelu_tanh(x[j]);
        st8bf(y + (size_t)m * SSMW + u.aux * GSZ + o8, z);
    }
    __device__ __forceinline__ void store8(const Unit& u, int r, int cg, const float (&a)[8], const float (&b)[8]) const {
        const int row = u.pm * 256 + r, col = u.pn * 256 + cg * 8; one(u, row, col, a); one(u, row, col + 128, b);
    }
};
struct EpiAO { static constexpr bool PAIR = false; const bf16_t* ga; bf16_t* t2;
    __device__ __forceinline__ void one(int m, int c, const float (&x)[8]) const { float g[8], y[8]; ld8bf(ga + (size_t)m * DM + c, g);
#pragma unroll
        for (int j = 0; j < 8; ++j) y[j] = g[j] * x[j];
        st8bf(t2 + (size_t)m * DM + c, y); }
    __device__ __forceinline__ void store8(const Unit& u, int r, int cg, const float (&a)[8], const float (&b)[8]) const { const int m = u.pm * 256 + r, c = u.pn * 256 + cg * 8; one(m, c, a); one(m, c + 128, b); }
};
struct EpiGLU { static constexpr bool PAIR = false; const bf16_t* gs; const bf16_t* t2; bf16_t* mrg;
    __device__ __forceinline__ void store8(const Unit& u, int r, int cg, const float (&a)[8], const float (&b)[8]) const {
        const int m = u.pm * 256 + r, oc = u.pn * 128 + cg * 8; float g[8], t[8], y[8]; ld8bf(gs + (size_t)m * DM + oc, g); ld8bf(t2 + (size_t)m * DM + oc, t);
#pragma unroll
        for (int j = 0; j < 8; ++j) y[j] = t[j] + g[j] * (a[j] * sigmoidf_fast(b[j]));
        st8bf(mrg + (size_t)m * DM + oc, y);
    }
};
struct EpiGLUQ { static constexpr bool PAIR = true; const bf16_t* gs; const bf16_t* t2; unsigned char* mq; unsigned char* ms;
    struct Ctx { u32x4 g[8], t[8]; };
    __device__ __forceinline__ Ctx prep(const Unit& u, int wr, int cg, int fr) const { Ctx c; const int oc = u.pn * 128 + cg * 8;
#pragma unroll
        for (int i = 0; i < 8; ++i) { const size_t m = (size_t)(u.pm * 256 + (i >> 2) * 128 + wr * 64 + (i & 3) * 16 + fr); c.g[i] = *(const u32x4*)(gs + m * DM + oc); c.t[i] = *(const u32x4*)(t2 + m * DM + oc); }
        return c; }
    __device__ __forceinline__ u32x2 row(const u32x4 gw, const u32x4 tw, const float (&a)[8], const float (&b)[8], unsigned& sb) const {
        float g[8], t[8], y[8]; unpack8(gw, g); unpack8(tw, t); float am = 0.f;
#pragma unroll
        for (int j = 0; j < 8; ++j) { y[j] = t[j] + g[j] * (a[j] * sigmoidf_fast(b[j])); am = fmaxf(am, fabsf(y[j])); }
        am = max_x16_x32(am);
        sb = mx_scale_byte(am); const float scl = __uint_as_float(sb << 23);
        u32x2 o; o.x = fp8x4_scaled(y[0], y[1], y[2], y[3], scl); o.y = fp8x4_scaled(y[4], y[5], y[6], y[7], scl); return o; }
    __device__ __forceinline__ void store_pair(const Unit& u, int r, int cg, const float (&a0)[8], const float (&b0)[8], const float (&a1)[8], const float (&b1)[8], const Ctx& x, int i) const {
        unsigned sb0, sb1; const u32x2 o0 = row(x.g[i], x.t[i], a0, b0, sb0), o1 = row(x.g[i + 1], x.t[i + 1], a1, b1, sb1);
        const int fq = cg & 3, wc = cg >> 2, odd = fq & 1; const size_t m = (size_t)(u.pm * 256 + r + 16 * odd); const int oc = u.pn * 128 + 32 * wc + 8 * (fq & 2);
        *(u32x4*)(mq + m * DM + oc) = pg8::pair_swap(o0, o1);
        ms[m * 64 + (oc >> 5)] = (unsigned char)(odd ? sb1 : sb0);
    }
};
struct EpiOut { static constexpr bool PAIR = false; const float* x; bf16_t* h1;
    __device__ __forceinline__ void one(int m, int c, const float (&v)[8]) const { const float* xp = x + (size_t)m * DM + c;
        const f32x4 x0 = *(const f32x4*)xp, x1 = *(const f32x4*)(xp + 4);
        const float y[8] = {x0[0] + v[0], x0[1] + v[1], x0[2] + v[2], x0[3] + v[3], x1[0] + v[4], x1[1] + v[5], x1[2] + v[6], x1[3] + v[7]};
        st8bf(h1 + (size_t)m * DM + c, y); }
    __device__ __forceinline__ void store8(const Unit& u, int r, int cg, const float (&a)[8], const float (&b)[8]) const { const int m = u.pm * 256 + r, c = u.pn * 256 + cg * 8; one(m, c, a); one(m, c + 128, b); }
};
struct EpiMoe1 { static constexpr bool PAIR = false; const float* b1; bf16_t* act;
    __device__ __forceinline__ void store8(const Unit& u, int r, int cg, const float (&a)[8], const float (&b)[8]) const {
        const int slot = u.pm * 256 + r, oc = u.pn * 128 + cg * 8; const float* bp = b1 + (size_t)u.aux * (2 * DFF) + 2 * oc; float bias[16];
#pragma unroll
        for (int j = 0; j < 4; ++j) { const f32x4 t = *(const f32x4*)(bp + 4 * j); bias[4 * j] = t[0]; bias[4 * j + 1] = t[1]; bias[4 * j + 2] = t[2]; bias[4 * j + 3] = t[3]; }
        float y[8];
#pragma unroll
        for (int j = 0; j < 8; ++j) { const float xg = fminf(a[j] + bias[2 * j], 7.0f); const float xl = fminf(fmaxf(b[j] + bias[2 * j + 1], -7.0f), 7.0f);
            y[j] = xg * sigmoidf_fast(1.702f * xg) * (xl + 1.0f); }
        st8bf(act + (size_t)slot * DFF + oc, y);
    }
};
struct EpiMoe1Q { static constexpr bool PAIR = true; const float* b1; unsigned char* actq; unsigned char* acts;
    struct Ctx { f32x4 t[4]; };
    __device__ __forceinline__ Ctx prep(const Unit& u, int, int cg, int) const { Ctx c; const float* bp = b1 + (size_t)u.aux * (2 * DFF) + 2 * (u.pn * 128 + cg * 8);
#pragma unroll
        for (int j = 0; j < 4; ++j) c.t[j] = *(const f32x4*)(bp + 4 * j);
        return c; }
    __device__ __forceinline__ u32x2 row(const float (&a)[8], const float (&b)[8], const float (&bias)[16], unsigned& sb) const {
        float y[8]; float am = 0.f;
#pragma unroll
        for (int j = 0; j < 8; ++j) { const float xg = fminf(a[j] + bias[2 * j], 7.0f); const float xl = fminf(fmaxf(b[j] + bias[2 * j + 1], -7.0f), 7.0f);
            y[j] = xg * sigmoidf_fast(1.702f * xg) * (xl + 1.0f); am = fmaxf(am, fabsf(y[j])); }
        am = max_x16_x32(am);
        sb = mx_scale_byte(am); const float scl = __uint_as_float(sb << 23);
        u32x2 o; o.x = fp8x4_scaled(y[0], y[1], y[2], y[3], scl); o.y = fp8x4_scaled(y[4], y[5], y[6], y[7], scl); return o; }
    __device__ __forceinline__ void store_pair(const Unit& u, int r, int cg, const float (&a0)[8], const float (&b0)[8], const float (&a1)[8], const float (&b1)[8], const Ctx& c, int) const {
        float bias[16];
#pragma unroll
        for (int j = 0; j < 4; ++j) { bias[4 * j] = c.t[j][0]; bias[4 * j + 1] = c.t[j][1]; bias[4 * j + 2] = c.t[j][2]; bias[4 * j + 3] = c.t[j][3]; }
        unsigned sb0, sb1; const u32x2 o0 = row(a0, b0, bias, sb0), o1 = row(a1, b1, bias, sb1);
        const int fq = cg & 3, wc = cg >> 2, odd = fq & 1; const int slot = u.pm * 256 + r + 16 * odd;
        *(u32x4*)(actq + (size_t)slot * DFF + u.pn * 128 + 32 * wc + 8 * (fq & 2)) = pg8::pair_swap(o0, o1);
        acts[((size_t)slot * 16 + u.pn) * 4 + wc] = (unsigned char)(odd ? sb1 : sb0);
    }
};
struct EpiMoe2Q { static constexpr bool PAIR = true; const float* b2; const float* sgate; unsigned char* ysq; unsigned char* yss;
    struct Ctx { f32x4 b[4]; float g[8]; };
    __device__ __forceinline__ Ctx prep(const Unit& u, int wr, int cg, int fr) const { Ctx c; const float* bp = b2 + (size_t)u.aux * DM + u.pn * 256 + cg * 8;
        c.b[0] = *(const f32x4*)bp; c.b[1] = *(const f32x4*)(bp + 4); c.b[2] = *(const f32x4*)(bp + 128); c.b[3] = *(const f32x4*)(bp + 132);
#pragma unroll
        for (int i = 0; i < 8; ++i) c.g[i] = sgate[u.pm * 256 + (i >> 2) * 128 + wr * 64 + (i & 3) * 16 + fr];
        return c; }
    __device__ __forceinline__ u32x2 row(float gt, const f32x4 b0, const f32x4 b1, const float (&v)[8], unsigned& sb) const {
        float y[8] = {(v[0] + b0[0]) * gt, (v[1] + b0[1]) * gt, (v[2] + b0[2]) * gt, (v[3] + b0[3]) * gt, (v[4] + b1[0]) * gt, (v[5] + b1[1]) * gt, (v[6] + b1[2]) * gt, (v[7] + b1[3]) * gt};
        float am = fmaxf(fmaxf(fmaxf(fabsf(y[0]), fabsf(y[1])), fmaxf(fabsf(y[2]), fabsf(y[3]))), fmaxf(fmaxf(fabsf(y[4]), fabsf(y[5])), fmaxf(fabsf(y[6]), fabsf(y[7]))));
        am = max_x16_x32(am);
        sb = mx_scale_byte(am); const float scl = __uint_as_float(sb << 23);
        u32x2 o; o.x = fp8x4_scaled(y[0], y[1], y[2], y[3], scl); o.y = fp8x4_scaled(y[4], y[5], y[6], y[7], scl); return o; }
    __device__ __forceinline__ void store_pair(const Unit& u, int r, int cg, const float (&a0)[8], const float (&b0)[8], const float (&a1)[8], const float (&b1)[8], const Ctx& x, int i) const {
        const int fq = cg & 3, wc = cg >> 2, odd = fq & 1; const int slot = u.pm * 256 + r + 16 * odd, c = u.pn * 256 + 32 * wc + 8 * (fq & 2); const float g0 = x.g[i], g1 = x.g[i + 1];
        unsigned sa0, sa1, sb0, sb1;
        const u32x2 oa0 = row(g0, x.b[0], x.b[1], a0, sa0), oa1 = row(g1, x.b[0], x.b[1], a1, sa1);
        *(u32x4*)(ysq + (size_t)slot * DM + c) = pg8::pair_swap(oa0, oa1);
        const int ba = c >> 5, bb_ = ba + 4;
        yss[(size_t)slot * 64 + ((ba & 7) << 3) + (ba >> 3)] = (unsigned char)(odd ? sa1 : sa0);
        const u32x2 ob0 = row(g0, x.b[2], x.b[3], b0, sb0), ob1 = row(g1, x.b[2], x.b[3], b1, sb1);
        *(u32x4*)(ysq + (size_t)slot * DM + c + 128) = pg8::pair_swap(ob0, ob1);
        yss[(size_t)slot * 64 + ((bb_ & 7) << 3) + (bb_ >> 3)] = (unsigned char)(odd ? sb1 : sb0);
    }
};
struct EpiMoe2 { static constexpr bool PAIR = false; const float* b2; const float* sgate; bf16_t* ys;
    __device__ __forceinline__ void one(int e, int slot, float gt, int c, const float (&v)[8]) const { const float* bp = b2 + (size_t)e * DM + c; const f32x4 b0 = *(const f32x4*)bp, b1 = *(const f32x4*)(bp + 4);
        float y[8] = {(v[0] + b0[0]) * gt, (v[1] + b0[1]) * gt, (v[2] + b0[2]) * gt, (v[3] + b0[3]) * gt, (v[4] + b1[0]) * gt, (v[5] + b1[1]) * gt, (v[6] + b1[2]) * gt, (v[7] + b1[3]) * gt};
        st8bf(ys + (size_t)slot * DM + c, y); }
    __device__ __forceinline__ void store8(const Unit& u, int r, int cg, const float (&a)[8], const float (&b)[8]) const {
        const int slot = u.pm * 256 + r, c = u.pn * 256 + cg * 8; const float gt = sgate[slot]; one(u.aux, slot, gt, c, a); one(u.aux, slot, gt, c + 128, b);
    }
};

namespace att {
constexpr int NW = 8, QBLK = 32, KVBLK = 64, LD = 1024;
constexpr int SHM_K = KVBLK * DH * 2, SHM_V = KVBLK * DV * 2;
constexpr int OFF_V = 0, OFF_K = 2 * SHM_V, OFF_WS = OFF_K + 2 * SHM_K, ATT_LDS = OFF_WS + NW * 64 * 4;
constexpr float THR = 8.0f;
constexpr int NT = SEQ / KVBLK + 1;
#define KSWZ64(row, chunk) ((row) * 128 + ((((chunk) ^ (((row) >> 1) & 7))) << 4))
#define SBAR() __builtin_amdgcn_sched_barrier(0)
__device__ __forceinline__ int crow(int r, int hi) { return (r & 3) + 8 * (r >> 2) + 4 * hi; }
__device__ __forceinline__ unsigned cvtpk(float lo, float hi) { unsigned r; asm volatile("v_cvt_pk_bf16_f32 %0, %1, %2" : "=v"(r) : "v"(lo), "v"(hi)); return r; }

template <int MODE>
__device__ __forceinline__ void partialSM(f32x16& p0, f32x16& p1, float& m_reg, float& mn, float& alpha, float dqh, float nslope, float c0, float c1) {
    if (MODE == 0) {
#pragma unroll
        for (int r = 0; r < 16; ++r) { if ((r >> 2) >= 2) p0[r] = -1e30f; p1[r] = -1e30f; }
    } else if (MODE == 1) {
#pragma unroll
        for (int r = 0; r < 16; ++r) { const float kk = (float)((r & 3) + 8 * (r >> 2)); p0[r] = fmaf(nslope, fabsf(dqh - kk), p0[r]); p1[r] = fmaf(nslope, fabsf(dqh - (kk + 32.f)), p1[r]); }
    }
    float pm0 = p0[0], pm1 = p1[0];
#pragma unroll
    for (int r = 1; r < 16; ++r) { pm0 = fmaxf(pm0, p0[r]); pm1 = fmaxf(pm1, p1[r]); }
    float pmax = (MODE == 2) ? fmaxf(pm0 + c0, pm1 + c1) : fmaxf(pm0, pm1);
    { auto rr = __builtin_amdgcn_permlane32_swap(__float_as_uint(pmax), __float_as_uint(pmax), false, false); pmax = fmaxf(__uint_as_float(rr[0]), __uint_as_float(rr[1])); }
    if (__builtin_expect(__all(pmax - m_reg <= THR), 1)) { mn = m_reg; alpha = 1.f; }
    else { mn = fmaxf(m_reg, pmax); alpha = __builtin_amdgcn_exp2f(m_reg - mn); m_reg = mn; }
    const float d0 = (MODE == 2) ? c0 - mn : -mn, d1 = (MODE == 2) ? c1 - mn : -mn;
#pragma unroll
    for (int r = 0; r < 16; ++r) { p0[r] += d0; p1[r] += d1; }
#pragma unroll
    for (int r = 0; r < 16; ++r) p0[r] = __builtin_amdgcn_exp2f(p0[r]);
}
__device__ __forceinline__ void finishSM(f32x16& p0, f32x16& p1, float alpha, float& l_reg, bf16x8& pa0, bf16x8& pa1, bf16x8& pa2, bf16x8& pa3) {
#pragma unroll
    for (int r = 0; r < 16; ++r) p1[r] = __builtin_amdgcn_exp2f(p1[r]);
    float ps = 0;
#pragma unroll
    for (int r = 0; r < 16; ++r) ps += p0[r];
#pragma unroll
    for (int r = 0; r < 16; ++r) ps += p1[r];
    { auto rr = __builtin_amdgcn_permlane32_swap(__float_as_uint(ps), __float_as_uint(ps), false, false); ps = __uint_as_float(rr[0]) + __uint_as_float(rr[1]); }
    l_reg = l_reg * alpha + ps;
#define PK4(P, BASE, OUT) do { unsigned a0 = cvtpk(P[BASE + 0], P[BASE + 1]), a1 = cvtpk(P[BASE + 2], P[BASE + 3]);   \
    unsigned b0 = cvtpk(P[BASE + 4], P[BASE + 5]), b1 = cvtpk(P[BASE + 6], P[BASE + 7]);                              \
    auto r0 = __builtin_amdgcn_permlane32_swap(a0, b0, false, false); auto r1 = __builtin_amdgcn_permlane32_swap(a1, b1, false, false); \
    u32x4 w = {r0[0], r1[0], r0[1], r1[1]}; OUT = *reinterpret_cast<bf16x8*>(&w); } while (0)
    PK4(p0, 0, pa0); PK4(p0, 8, pa1); PK4(p1, 0, pa2); PK4(p1, 8, pa3);
#undef PK4
}
__device__ __forceinline__ void qkt(f32x16& p0, f32x16& p1, const char* Ks, const bf16x8* qr, int r32, int hi, float sg) {
    f32x16 iv; const float sgh = sg * (float)(4 * hi);
#pragma unroll
    for (int r = 0; r < 16; ++r) iv[r] = fmaf(sg, (float)((r & 3) + 8 * (r >> 2)), sgh);
#pragma unroll
    for (int d0 = 0; d0 < 4; ++d0) { const int ch = d0 * 2 + hi;
        const bf16x8 b0 = *reinterpret_cast<const bf16x8*>(Ks + KSWZ64(r32, ch));
        const bf16x8 b1 = *reinterpret_cast<const bf16x8*>(Ks + KSWZ64(32 + r32, ch));
        p0 = __builtin_amdgcn_mfma_f32_32x32x16_bf16(b0, qr[d0], d0 == 0 ? iv : p0, 0, 0, 0);
        p1 = __builtin_amdgcn_mfma_f32_32x32x16_bf16(b1, qr[d0], d0 == 0 ? iv : p1, 0, 0, 0); }
}
__device__ __forceinline__ int v_st(int k, int c) { const int kk = (k & ~0xC) | ((k & 4) << 1) | ((k & 8) >> 1); return ((kk >> 3) * 4 + (c >> 5)) * 512 + ((kk & 7) * 32 + (c & 31)) * 2; }
__device__ __forceinline__ int v_rd_base(int lane) { return ((lane & 3) << 3) | (((lane >> 2) & 3) << 6) | (((lane >> 4) & 1) << 5) | (((lane >> 5) & 1) << 8); }
constexpr int v_rd_off(int d0, int ks, int half) { return d0 * 512 + ks * 4096 + half * 2048; }
template <int OFF> __device__ __forceinline__ s16x4 tr_read(int vb) { s16x4 r; asm volatile("ds_read_b64_tr_b16 %0, %1 offset:%2" : "=&v"(r) : "v"(vb), "i"(OFF) : "memory"); return r; }
template <int D0> __device__ __forceinline__ void pv_one(f32x16& od, int vb, bf16x8 pa0, bf16x8 pa1, bf16x8 pa2, bf16x8 pa3) {
    const s16x4 l0 = tr_read<v_rd_off(D0, 0, 0)>(vb), h0 = tr_read<v_rd_off(D0, 0, 1)>(vb), l1 = tr_read<v_rd_off(D0, 1, 0)>(vb), h1 = tr_read<v_rd_off(D0, 1, 1)>(vb);
    const s16x4 l2 = tr_read<v_rd_off(D0, 2, 0)>(vb), h2 = tr_read<v_rd_off(D0, 2, 1)>(vb), l3 = tr_read<v_rd_off(D0, 3, 0)>(vb), h3 = tr_read<v_rd_off(D0, 3, 1)>(vb);
    asm volatile("s_waitcnt lgkmcnt(0)" ::: "memory"); SBAR();
#define PK(L, H) (bf16x8){L[0], L[1], L[2], L[3], H[0], H[1], H[2], H[3]}
    od = __builtin_amdgcn_mfma_f32_32x32x16_bf16(pa0, PK(l0, h0), od, 0, 0, 0);
    od = __builtin_amdgcn_mfma_f32_32x32x16_bf16(pa1, PK(l1, h1), od, 0, 0, 0);
    od = __builtin_amdgcn_mfma_f32_32x32x16_bf16(pa2, PK(l2, h2), od, 0, 0, 0);
    od = __builtin_amdgcn_mfma_f32_32x32x16_bf16(pa3, PK(l3, h3), od, 0, 0, 0);
#undef PK
}
__device__ __forceinline__ void pv_d0(f32x16* o, int vb, bf16x8 pa0, bf16x8 pa1, bf16x8 pa2, bf16x8 pa3) {
    pv_one<0>(o[0], vb, pa0, pa1, pa2, pa3); pv_one<1>(o[1], vb, pa0, pa1, pa2, pa3); pv_one<2>(o[2], vb, pa0, pa1, pa2, pa3); pv_one<3>(o[3], vb, pa0, pa1, pa2, pa3);
}
__device__ __forceinline__ void attn_unit(const bf16_t* __restrict__ Qb, const bf16_t* __restrict__ Kh, const bf16_t* __restrict__ Vh, const bf16_t* __restrict__ Km, const bf16_t* __restrict__ Vm,
                                          bf16_t* __restrict__ Ob, int q0, float nslope, char* lds, int t_lo, int n) {
#define TL(s_) (((s_) == 0) ? 0 : t_lo + (s_) - 1)
    const int tid = threadIdx.x, wid = tid >> 6, lane = tid & 63, r32 = lane & 31, hi = lane >> 5;
    char* V_lds = lds + OFF_V; char* K_lds = lds + OFF_K;
    float* ws = (float*)(lds + OFF_WS) + wid * 64; float* li_l = ws; float* al_l = ws + 32;
    float m_reg = -1e30f, l_reg = 0; f32x16 o[4] = {}; bf16x8 qr[4];
    const bf16_t* Qw = Qb + (long)(wid * QBLK + r32) * LD + hi * 8;
#pragma unroll
    for (int d0 = 0; d0 < 4; ++d0) qr[d0] = *reinterpret_cast<const bf16x8*>(Qw + d0 * 16);
    const int sr = tid >> 4, sc = (tid & 15) * 8, vst0 = v_st(sr, sc), vst1 = v_st(32 + sr, sc);
    const int skr = tid >> 3, skc = tid & 7, kst = KSWZ64(skr, skc);
    const int vb0 = (int)(uintptr_t)V_lds + v_rd_base(lane);
    struct { bf16x8 vs0, vs1, ks; } sr_[2];
    const float qpos = (float)(q0 + wid * QBLK + r32) - 4.0f * (float)hi;
#define SLOAD(i, t) do { const int t_ = (t); const bf16_t* kp_ = (t_ == 0) ? Km : Kh + (long)(t_ - 1) * KVBLK * LD; const bf16_t* vp_ = (t_ == 0) ? Vm : Vh + (long)(t_ - 1) * KVBLK * LD; \
    sr_[i].vs0 = *reinterpret_cast<const bf16x8*>(vp_ + (long)sr * LD + sc); sr_[i].vs1 = *reinterpret_cast<const bf16x8*>(vp_ + (long)(32 + sr) * LD + sc); \
    sr_[i].ks = *reinterpret_cast<const bf16x8*>(kp_ + (long)skr * LD + skc * 8); } while (0)
#define SWRITE(b, i) do { *(bf16x8*)(V_lds + (b) * SHM_V + vst0) = sr_[i].vs0; *(bf16x8*)(V_lds + (b) * SHM_V + vst1) = sr_[i].vs1; *(bf16x8*)(K_lds + (b) * SHM_K + kst) = sr_[i].ks; } while (0)
#define RESC(a) do { if (__any((a) < 1.f)) { if (hi == 0) al_l[r32] = (a); asm volatile("s_waitcnt lgkmcnt(0)" ::: "memory"); \
    _Pragma("unroll") for (int d = 0; d < 4; ++d) _Pragma("unroll") for (int r = 0; r < 16; ++r) o[d][r] *= al_l[crow(r, hi)]; } } while (0)
#define DQ(t) (qpos - (float)(((t) - 1) * KVBLK))
    const int qlo = q0 + wid * QBLK; const float sl2 = -nslope, qposf = (float)(qlo + r32);
#define TSIDE(t) ((((t) - 1) * KVBLK + KVBLK - 1 < qlo) ? 1 : ((((t) - 1) * KVBLK > qlo + QBLK - 1) ? -1 : 0))
#define PSM(P0, P1, MN, AL, t) do { const int sd_ = TSIDE(t); \
        if (sd_ == 0) partialSM<1>(P0, P1, m_reg, MN, AL, DQ(t), nslope, 0.f, 0.f); \
        else { const float sg_ = sd_ > 0 ? sl2 : -sl2; const float c0_ = sg_ * ((float)(((t) - 1) * KVBLK) - qposf); partialSM<2>(P0, P1, m_reg, MN, AL, 0.f, nslope, c0_, c0_ + 32.f * sg_); } } while (0)
#define QKT(P0, P1, KS, t) do { const int sd_ = TSIDE(t); qkt(P0, P1, KS, qr, r32, hi, sd_ > 0 ? sl2 : (sd_ < 0 ? -sl2 : 0.f)); } while (0)
    f32x16 pA0, pA1, pB0, pB1; float mnA, mnB, alA, alB; bf16x8 pa0, pa1, pa2, pa3;
    constexpr int SE = 0, SO = 1;
    SLOAD(SE, 0); asm volatile("s_waitcnt vmcnt(0)" ::: "memory"); SWRITE(0, SE); __syncthreads();
    qkt(pA0, pA1, K_lds, qr, r32, hi, 0.f); partialSM<0>(pA0, pA1, m_reg, mnA, alA, 0.f, nslope, 0.f, 0.f);
    SLOAD(SO, TL(1)); SLOAD(SE, TL(2));
    asm volatile("s_waitcnt vmcnt(3)" ::: "memory"); SWRITE(1, SO); __syncthreads();
    for (int j = 1; j + 1 < n; j += 2) {
        const int tj = TL(j), tj1 = tj + 1;
        SBAR(); QKT(pB0, pB1, K_lds + SHM_K, tj);
        finishSM(pA0, pA1, alA, l_reg, pa0, pa1, pa2, pa3); SBAR();
        if (j + 2 < n) SLOAD(SO, tj + 2);
        SBAR();
        pv_d0(o, vb0, pa0, pa1, pa2, pa3); PSM(pB0, pB1, mnB, alB, tj);
        __syncthreads(); if (j + 2 < n) asm volatile("s_waitcnt vmcnt(3)" ::: "memory"); SWRITE(0, SE);
        RESC(alB); __syncthreads();
        SBAR(); QKT(pA0, pA1, K_lds, tj1);
        finishSM(pB0, pB1, alB, l_reg, pa0, pa1, pa2, pa3); SBAR();
        if (j + 3 < n) SLOAD(SE, tj + 3);
        SBAR();
        pv_d0(o, vb0 + SHM_V, pa0, pa1, pa2, pa3); PSM(pA0, pA1, mnA, alA, tj1);
        __syncthreads();
        if (j + 2 < n) { if (j + 3 < n) asm volatile("s_waitcnt vmcnt(3)" ::: "memory"); SWRITE(1, SO); }
        RESC(alA); __syncthreads();
    }
    finishSM(pA0, pA1, alA, l_reg, pa0, pa1, pa2, pa3); SBAR();
    pv_d0(o, vb0, pa0, pa1, pa2, pa3);
    if (hi == 0) li_l[r32] = l_reg; asm volatile("s_waitcnt lgkmcnt(0)" ::: "memory");
    float rli[16];
#pragma unroll
    for (int r = 0; r < 16; ++r) rli[r] = __builtin_amdgcn_rcpf(li_l[crow(r, hi)]);
    bf16_t* Ow = Ob + (long)(wid * QBLK) * 2048;
#pragma unroll
    for (int r = 0; r < 16; ++r) { const int orow = crow(r, hi);
#pragma unroll
        for (int d0 = 0; d0 < 4; ++d0) Ow[(long)orow * 2048 + d0 * 32 + r32] = (bf16_t)(pk_bf16(o[d0][r] * rli[r], 0.f) & 0xffffu); }
    __syncthreads();
#undef SLOAD
#undef SWRITE
#undef RESC
#undef DQ
#undef TSIDE
#undef PSM
#undef QKT
#undef TL
}
static_assert((NT & 1) == 1, "the tail assumes an odd tile count");
}

#define XB_TMO      128
#define XB_XCNT(j)  (256  + 64 * (j))
#define XB_XSUB(j)  (1280 + 64 * (j))
#define XB_XGEN(j)  (2304 + 64 * (j))
#define XB_TOP      3328
#define XB_TOPGEN   3392
#define XCD_BAR_WORDS 3456
#define XB_SPIN_CAP (1u << 18)
__device__ __forceinline__ unsigned xb_ld(unsigned* p)              { return __hip_atomic_load(p, __ATOMIC_RELAXED, __HIP_MEMORY_SCOPE_AGENT); }
__device__ __forceinline__ unsigned xb_add(unsigned* p, unsigned v) { return __hip_atomic_fetch_add(p, v, __ATOMIC_RELAXED, __HIP_MEMORY_SCOPE_AGENT); }
__device__ __forceinline__ unsigned xb_xcc_id() { return (unsigned)__builtin_amdgcn_s_getreg((3 << 11) | 20) & 0xFu; }
#define XB_SPIN(cond, bar) do { unsigned _sp = 0; while (cond) { __builtin_amdgcn_s_sleep(1); \
    if ((++_sp & 255u) == 0u) { if (xb_ld(&(bar)[XB_TMO])) break; if (_sp > XB_SPIN_CAP) { atomicAdd(&(bar)[XB_TMO], 1u); break; } } } } while (0)
struct XcdBarrier { unsigned* bar; unsigned x; volatile LAS unsigned* st; };
__device__ __forceinline__ XcdBarrier xcd_barrier_post(unsigned* bar, volatile LAS unsigned* st) {
    XcdBarrier b; b.bar = bar; b.x = xb_xcc_id(); b.st = st;
    if (threadIdx.x == 0) (void)xb_add(&bar[XB_XCNT(b.x)], 1u);
    return b;
}
__device__ __forceinline__ void xcd_barrier_complete(unsigned* bar, unsigned x, unsigned& nloc, unsigned& nx) {
    const unsigned G = gridDim.x * gridDim.y * gridDim.z;
    unsigned sum, cnt, mine, sp = 0u;
    for (;;) {
        sum = 0u; cnt = 0u; mine = 0u;
#pragma unroll
        for (unsigned j = 0; j < 16; ++j) { const unsigned c = xb_ld(&bar[XB_XCNT(j)]); sum += c; cnt += (c > 0u) ? 1u : 0u; mine = (j == x) ? c : mine; }
        if (sum == G) break;
        __builtin_amdgcn_s_sleep(1);
        if ((++sp & 255u) == 0u) { if (xb_ld(&bar[XB_TMO])) break; if (sp > XB_SPIN_CAP) { atomicAdd(&bar[XB_TMO], 1u); break; } }
    }
    nloc = mine > 0u ? mine : 1u; nx = cnt > 0u ? cnt : 1u;
}
__device__ __forceinline__ void xcd_barrier(const XcdBarrier& b) {
    asm volatile("s_waitcnt vmcnt(0)" ::: "memory");
    __syncthreads();
    if (threadIdx.x == 0) {
        unsigned* bar = b.bar;
        __builtin_amdgcn_s_waitcnt(0);
        unsigned nloc = b.st[0], nx = b.st[1];
        if (nloc == 0u) { xcd_barrier_complete(bar, b.x, nloc, nx); b.st[0] = nloc; b.st[1] = nx; }
        const unsigned old = xb_add(&bar[XB_XSUB(b.x)], 1u);
        const unsigned gen = old / nloc;
        if (old + 1u == (gen + 1u) * nloc) {
            __builtin_amdgcn_fence(__ATOMIC_RELEASE, "agent");
            asm volatile("s_waitcnt vmcnt(0)" ::: "memory");
            const unsigned og = xb_add(&bar[XB_TOP], 1u);
            const unsigned tg = og / nx;
            if (og + 1u == (tg + 1u) * nx) xb_add(&bar[XB_TOPGEN], 1u);
            else XB_SPIN(xb_ld(&bar[XB_TOPGEN]) == tg, bar);
            __builtin_amdgcn_fence(__ATOMIC_ACQUIRE, "agent");
            xb_add(&bar[XB_XGEN(b.x)], 1u);
            asm volatile("s_waitcnt vmcnt(0)" ::: "memory");
        } else {
            XB_SPIN(xb_ld(&bar[XB_XGEN(b.x)]) == gen, bar);
            __builtin_amdgcn_fence(__ATOMIC_ACQUIRE, "agent");
            asm volatile("s_waitcnt vmcnt(0)" ::: "memory");
        }
    }
    __syncthreads();
}

struct Args { const float* in[35]; float* out; unsigned char* ws; int ph_lo, ph_hi; };
enum { I_X = 0, I_META, I_GMIX, I_WIN, I_LRF, I_LIF, I_DTF, I_BRF, I_BIF, I_CRF, I_CIF, I_LRB, I_LIB, I_DTB, I_BRB, I_BIB, I_CRB, I_CIB, I_SSMD, I_WGLU,
       I_LQ1, I_LK1, I_LQ2, I_LK2, I_SUBG, I_WAO, I_WOUT, I_GMOE, I_WR, I_BR, I_WE1, I_BE1, I_WE2, I_BE2, I_GFIN };
constexpr int NPHASE = 15;

template <class RM>
__device__ __forceinline__ void transpose_item(const float* W, int K, int N, bf16_t* WT, const RM rm, LAS float* scr, int item, int lane, int ldw = 0) {
    if (ldw == 0) ldw = N;
    const int nblk = N / 64, kb = item / nblk, nb = item % nblk, k0 = 64 * kb, n0 = 64 * nb;
    const int lr = lane >> 4, lc = (lane & 15) * 4;
    f32x4 v[16];
#pragma unroll
    for (int i = 0; i < 16; ++i) v[i] = *(const f32x4*)(W + (size_t)(k0 + 4 * i + lr) * ldw + n0 + lc);
#pragma unroll
    for (int i = 0; i < 16; ++i) { LAS float* p = scr + (4 * i + lr) * 65 + lc; p[0] = v[i][0]; p[1] = v[i][1]; p[2] = v[i][2]; p[3] = v[i][3]; }
    LDS_WAIT(); asm volatile("" ::: "memory");
    const int c = lane & 7;
#pragma unroll
    for (int q = 0; q < 8; ++q) { const int n = q * 8 + (lane >> 3); const LAS float* sp = scr + (8 * c) * 65 + n;
        u32x4 o; o.x = pk_bf16(sp[0 * 65], sp[1 * 65]); o.y = pk_bf16(sp[2 * 65], sp[3 * 65]); o.z = pk_bf16(sp[4 * 65], sp[5 * 65]); o.w = pk_bf16(sp[6 * 65], sp[7 * 65]);
        *(u32x4*)(WT + (size_t)rm(n0 + n) * K + k0 + 8 * c) = o; }
    LDS_WAIT(); asm volatile("" ::: "memory");
}
template <class RM>
__device__ __forceinline__ void transpose_item_q(const float* W, int K, int N, unsigned char* WQ, unsigned char* WSC, const RM rm, LAS float* scr, int item, int lane, int ldw = 0) {
    if (ldw == 0) ldw = N;
    const int nblk = N / 32, kb = item / nblk, nb = item % nblk, k0 = 128 * kb, n0 = 32 * nb;
    const int lr = lane >> 3, lc = (lane & 7) * 4;
    f32x4 v[16];
#pragma unroll
    for (int i = 0; i < 16; ++i) v[i] = *(const f32x4*)(W + (size_t)(k0 + 8 * i + lr) * ldw + n0 + lc);
#pragma unroll
    for (int i = 0; i < 16; ++i) { LAS float* p = scr + (8 * i + lr) * 33 + lc; p[0] = v[i][0]; p[1] = v[i][1]; p[2] = v[i][2]; p[3] = v[i][3]; }
    LDS_WAIT(); asm volatile("" ::: "memory");
    const int n = lane & 31, c2 = lane >> 5; const size_t row = (size_t)rm(n0 + n);
    unsigned char* dst = WQ + row * K + k0 + 64 * c2; unsigned sw = 0;
#pragma unroll
    for (int blk = 0; blk < 2; ++blk) { const LAS float* sp = scr + (64 * c2 + 32 * blk) * 33 + n; float x[32]; float am = 0.f;
#pragma unroll
        for (int j = 0; j < 32; ++j) { x[j] = sp[j * 33]; am = fmaxf(am, fabsf(x[j])); }
        const unsigned sb = mx_scale_byte(am); const float inv = mx_inv_scale(sb); sw |= sb << (8 * blk);
#pragma unroll
        for (int h = 0; h < 2; ++h) { u32x4 o;
            o.x = fp8x4(x[16 * h + 0] * inv, x[16 * h + 1] * inv, x[16 * h + 2] * inv, x[16 * h + 3] * inv); o.y = fp8x4(x[16 * h + 4] * inv, x[16 * h + 5] * inv, x[16 * h + 6] * inv, x[16 * h + 7] * inv);
            o.z = fp8x4(x[16 * h + 8] * inv, x[16 * h + 9] * inv, x[16 * h + 10] * inv, x[16 * h + 11] * inv); o.w = fp8x4(x[16 * h + 12] * inv, x[16 * h + 13] * inv, x[16 * h + 14] * inv, x[16 * h + 15] * inv);
            *(u32x4*)(dst + 32 * blk + 16 * h) = o; } }
    const unsigned other = (unsigned)__shfl_xor((int)sw, 32);
    if (c2 == 0) *(unsigned*)(WSC + (row * (K / 128) + kb) * 4) = sw | (other << 16);
    LDS_WAIT(); asm volatile("" ::: "memory");
}
struct RmId { __device__ __forceinline__ int operator()(int n) const { return n; } };
struct RmGlu { __device__ __forceinline__ int operator()(int n) const { const int j = n & 2047, hb = n >> 11; return 256 * (j >> 7) + 128 * hb + (j & 127); } };
struct RmE1 { __device__ __forceinline__ int operator()(int n) const { const int j = n >> 1, lin = n & 1; return 256 * (j >> 7) + 128 * lin + (j & 127); } };

__device__ __forceinline__ void rms_row_bf16(const float* xrow, const float* gain, bf16_t* orow, int lane, unsigned char* qrow = nullptr, unsigned char* qscl = nullptr) {
    f32x4 v[8]; float s = 0.f;
#pragma unroll
    for (int j = 0; j < 8; ++j) { v[j] = *(const f32x4*)(xrow + j * 256 + lane * 4); s += (v[j][0] * v[j][0] + v[j][1] * v[j][1]) + (v[j][2] * v[j][2] + v[j][3] * v[j][3]); }
    const float r = 1.0f / sqrtf(wave_sum(s) * (1.0f / DM) + EPS);
#pragma unroll
    for (int j = 0; j < 8; ++j) { const f32x4 g = *(const f32x4*)(gain + j * 256 + lane * 4);
        const float y0 = v[j][0] * r * g[0], y1 = v[j][1] * r * g[1], y2 = v[j][2] * r * g[2], y3 = v[j][3] * r * g[3];
        u32x2 w; w.x = pk_bf16(y0, y1); w.y = pk_bf16(y2, y3);
        *(u32x2*)(orow + j * 256 + lane * 4) = w;
        if (qrow) {
            float am = fmaxf(fmaxf(fabsf(y0), fabsf(y1)), fmaxf(fabsf(y2), fabsf(y3)));
            am = fmaxf(am, __shfl_xor(am, 1)); am = fmaxf(am, __shfl_xor(am, 2)); am = fmaxf(am, __shfl_xor(am, 4));
            const unsigned sb = mx_scale_byte(am); const float inv = mx_inv_scale(sb); const int chunk = 2 * j + (lane >> 5), kk = (lane & 31) * 4;
            *(unsigned*)(qrow + chunk * 128 + kk) = fp8x4(y0 * inv, y1 * inv, y2 * inv, y3 * inv);
            if ((lane & 7) == 0) qscl[chunk * 4 + (kk >> 5)] = (unsigned char)sb; } }
}

__device__ __forceinline__ void ssm_build_group(const Args& A, int g, LAS unsigned char* lds) {
    LAS float* AP = (LAS float*)lds;
    LAS float* BB = AP + 2 * 33 * 64 * 2;
    LAS float* CC = BB + 2 * 64 * 16 * 2;
    LAS float* KT = CC + 2 * 16 * 64 * 2;
    const int tid = threadIdx.x;
    for (int idx = tid; idx < 2 * 33 * 64; idx += NTHREADS) {
        const int d = idx / (33 * 64), rem = idx % (33 * 64), e = rem / 64, p = rem % 64;
        const float lr = A.in[d ? I_LRB : I_LRF][g * 64 + p], li = A.in[d ? I_LIB : I_LIF][g * 64 + p], dt = expf(A.in[d ? I_DTB : I_DTF][g]);
        const float mag = expf(lr * dt * (float)e), ang = li * dt * (float)e; float sn, cs; sincosf(ang, &sn, &cs);
        AP[idx * 2] = mag * cs; AP[idx * 2 + 1] = mag * sn;
    }
    for (int idx = tid; idx < 2 * 16 * 64; idx += NTHREADS) {
        const int d = idx / 1024, rem = idx % 1024;
        CC[idx * 2] = A.in[d ? I_CRB : I_CRF][g * 1024 + rem]; CC[idx * 2 + 1] = A.in[d ? I_CIB : I_CIF][g * 1024 + rem];
    }
    __syncthreads();
    for (int idx = tid; idx < 2 * 64 * 16; idx += NTHREADS) {
        const int d = idx / 1024, rem = idx % 1024, p = rem / 16;
        const float lr = A.in[d ? I_LRB : I_LRF][g * 64 + p], li = A.in[d ? I_LIB : I_LIF][g * 64 + p];
        const float ar = AP[((d * 33 + 1) * 64 + p) * 2], ai = AP[((d * 33 + 1) * 64 + p) * 2 + 1];
        const float den = lr * lr + li * li, fr = ((ar - 1.0f) * lr + ai * li) / den, fi = (ai * lr - (ar - 1.0f) * li) / den;
        const float bre = A.in[d ? I_BRB : I_BRF][g * 1024 + rem], bim = A.in[d ? I_BIB : I_BIF][g * 1024 + rem];
        BB[idx * 2] = fr * bre - fi * bim; BB[idx * 2 + 1] = fr * bim + fi * bre;
    }
    __syncthreads();
    for (int idx = tid; idx < 2 * 32 * 16; idx += NTHREADS) {
        const int d = idx / 512, rem = idx % 512, dl = rem / 16, o = rem % 16;
        float acc[16];
#pragma unroll
        for (int i = 0; i < 16; ++i) acc[i] = 0.f;
        for (int p = 0; p < 64; ++p) {
            const float cr = CC[((d * 16 + o) * 64 + p) * 2], ci = CC[((d * 16 + o) * 64 + p) * 2 + 1];
            const float ar = AP[((d * 33 + dl) * 64 + p) * 2], ai = AP[((d * 33 + dl) * 64 + p) * 2 + 1];
            const float xr = cr * ar - ci * ai, xi = cr * ai + ci * ar;
            const LAS float* bp = BB + ((d * 64 + p) * 16) * 2;
#pragma unroll
            for (int i = 0; i < 16; ++i) acc[i] += xr * bp[2 * i] - xi * bp[2 * i + 1];
        }
#pragma unroll
        for (int i = 0; i < 16; ++i) KT[((d * 32 + dl) * 16 + o) * 16 + i] = acc[i];
    }
    __syncthreads();
    bf16_t* Bt3 = (bf16_t*)(A.ws + WS_BT3) + (size_t)g * 512 * UEXT_LD;
    bf16_t* Wst = (bf16_t*)(A.ws + WS_WST) + (size_t)g * 256 * 512;
    const float* Dv = A.in[I_SSMD] + g * 16;
    for (int piece = tid; piece < 512 * 64; piece += NTHREADS) {
        const int n = piece >> 6, kc = piece & 63, tau = n >> 4, o = n & 15, s = kc >> 1, i0 = (kc & 1) * 8; float v[8];
#pragma unroll
        for (int j = 0; j < 8; ++j) { const int i = i0 + j; float x;
            if (s < tau) x = KT[((0 * 32 + (tau - s)) * 16 + o) * 16 + i];
            else if (s > tau) x = KT[((1 * 32 + (s - tau)) * 16 + o) * 16 + i];
            else x = KT[(o) * 16 + i] + KT[((32) * 16 + o) * 16 + i] + ((o == i) ? Dv[o] : 0.f);
            v[j] = x; }
        st8bf(Bt3 + (size_t)n * UEXT_LD + kc * 8, v);
    }
    for (int piece = tid; piece < 512 * 32; piece += NTHREADS) {
        const int n = piece >> 5, pc = piece & 31, tau = n >> 4, o = n & 15, d = pc >> 4, p0 = (pc & 15) * 4, e = d ? (32 - tau) : (tau + 1); float v[8];
#pragma unroll
        for (int j = 0; j < 4; ++j) { const int p = p0 + j;
            const float cr = CC[((d * 16 + o) * 64 + p) * 2], ci = CC[((d * 16 + o) * 64 + p) * 2 + 1];
            const float ar = AP[((d * 33 + e) * 64 + p) * 2], ai = AP[((d * 33 + e) * 64 + p) * 2 + 1];
            v[2 * j] = cr * ar - ci * ai; v[2 * j + 1] = -(cr * ai + ci * ar); }
        st8bf(Bt3 + (size_t)n * UEXT_LD + 512 + pc * 8, v);
    }
    for (int piece = tid; piece < 256 * 64; piece += NTHREADS) {
        const int n = piece >> 6, kc = piece & 63, tau = kc >> 1, i0 = (kc & 1) * 8, d = n >> 7, p = (n & 127) >> 1, c = n & 1, e = d ? tau : (31 - tau); float v[8];
        const float ar = AP[((d * 33 + e) * 64 + p) * 2], ai = AP[((d * 33 + e) * 64 + p) * 2 + 1];
#pragma unroll
        for (int j = 0; j < 8; ++j) { const float br = BB[((d * 64 + p) * 16 + i0 + j) * 2], bi = BB[((d * 64 + p) * 16 + i0 + j) * 2 + 1];
            v[j] = c ? (ar * bi + ai * br) : (ar * br - ai * bi); }
        st8bf(Wst + (size_t)n * 512 + kc * 8, v);
    }
    __syncthreads();
}

__global__ void __launch_bounds__(NTHREADS, 2) mk_fwd(Args A) {
    extern __shared__ __attribute__((aligned(16))) unsigned char lds_raw[];
    LAS unsigned char* lds = (LAS unsigned char*)lds_raw;
    const int tid = threadIdx.x, lane = tid & 63, wave = __builtin_amdgcn_readfirstlane(tid >> 6);
    const int G = gridDim.x, bx = blockIdx.x, vcu = (G % 8 == 0) ? (bx % 8) * (G / 8) + bx / 8 : bx;
    const int gw = vcu * NWAVES + wave, NGW = G * NWAVES;
    unsigned char* ws = A.ws;
    unsigned* ctl = (unsigned*)(ws + WS_CTL);
    volatile LAS unsigned* MISC = (volatile LAS unsigned*)(lds + MISC_OFF);
    LAS int* tstart = (LAS int*)(lds + LDSCTL_OFF);
    for (int u = tid; u < (LDS_BYTES - LDSCTL_OFF) / 4; u += NTHREADS) ((LAS unsigned*)(lds + LDSCTL_OFF))[u] = 0u;
    __syncthreads();
#if MK_FUSED
    XcdBarrier bar = xcd_barrier_post(ctl + CW_BAR, MISC + 8);
#define GRID_BAR() xcd_barrier(bar)
#else
#define GRID_BAR() do { } while (0)
#endif
    const int lo = A.ph_lo, hi_ = A.ph_hi;
#ifndef PH_MASK
#define PH_MASK 0x7fff
#endif
#define IN(k) (((PH_MASK >> (k)) & 1) && lo <= (k) && (k) < hi_)
#define BOTH(k) (IN(k) && IN((k) + 1))
#define REP(k) for (int rep_ = 0; rep_ < ((((DBL_MASK) >> (k)) & 1) ? 2 : 1); ++rep_)

    bf16_t* Wt_in = (bf16_t*)(ws + WS_WIN); bf16_t* Wt_glu = (bf16_t*)(ws + WS_WGLU); bf16_t* Wt_ao = (bf16_t*)(ws + WS_WAO); bf16_t* Wt_out = (bf16_t*)(ws + WS_WOUT);
    bf16_t* Wt_e1 = (bf16_t*)(ws + WS_WE1); bf16_t* Wt_e2 = (bf16_t*)(ws + WS_WE2);
    bf16_t* XN = (bf16_t*)(ws + WS_XN); bf16_t* UEXT = (bf16_t*)(ws + WS_UEXT); bf16_t* QB = (bf16_t*)(ws + WS_Q); bf16_t* KB = (bf16_t*)(ws + WS_K); bf16_t* VB = (bf16_t*)(ws + WS_V);
    bf16_t* GS = (bf16_t*)(ws + WS_GS); bf16_t* GA = (bf16_t*)(ws + WS_GA); float* SB = (float*)(ws + WS_S); bf16_t* YB = (bf16_t*)(ws + WS_Y);
    bf16_t* OP = (bf16_t*)(ws + WS_OP); bf16_t* OB = (bf16_t*)(ws + WS_O); bf16_t* T2 = (bf16_t*)(ws + WS_T2); bf16_t* MRG = (bf16_t*)(ws + WS_MRG); bf16_t* HN = (bf16_t*)(ws + WS_HN);
    bf16_t* ACT = (bf16_t*)(ws + WS_ACT); bf16_t* YS = (bf16_t*)(ws + WS_YS);
    bf16_t* XNM = (bf16_t*)(ws + WS_MISC + MISC_XNM); float* UM = (float*)(ws + WS_MISC + MISC_UM); bf16_t* KM = (bf16_t*)(ws + WS_MISC + MISC_KM); bf16_t* VM = (bf16_t*)(ws + WS_MISC + MISC_VM);
    bf16_t* WFH = (bf16_t*)(ws + WS_MISC + 1024 * 1024); bf16_t* WFL = (bf16_t*)(ws + WS_MISC + 1280 * 1024);
    u32x2* TOKR = (u32x2*)(ws + WS_ROUTE + RT_E); int* TOK_SLOT = (int*)(ws + WS_ROUTE + RT_SLOT);
    int* SLOT_TOK = (int*)(ws + WS_ROUTE + RT_STOK); float* SLOT_GATE = (float*)(ws + WS_ROUTE + RT_SGATE);
    bf16_t* H1B = (bf16_t*)(ws + WS_T2);
    unsigned char* W1Q = (unsigned char*)(ws + WS_WE1); unsigned char* W2Q = (unsigned char*)(ws + WS_WE2); unsigned char* HNQ = (unsigned char*)(ws + WS_HN); unsigned char* ACTQ = (unsigned char*)(ws + WS_ACT);
    unsigned char* XNQ = (unsigned char*)(ws + WS_XNQ); unsigned char* XNS = (unsigned char*)(ws + WS_XNS); unsigned char* WGQ = (unsigned char*)(ws + WS_WGQ); unsigned char* WGS = (unsigned char*)(ws + WS_WGS);
    unsigned char* WOQ = (unsigned char*)(ws + WS_WOUT); unsigned char* WOS = (unsigned char*)(ws + WS_WOUT + 4 * MiB); unsigned char* MRGQ = (unsigned char*)(ws + WS_MRG); unsigned char* MRGS = (unsigned char*)(ws + WS_MRG + 32 * MiB);
    unsigned char* HNQL = (unsigned char*)(ws + WS_HNL); unsigned char* HNSL = (unsigned char*)(ws + WS_HNLS);
    unsigned char* YSQ = (unsigned char*)(ws + WS_YS); unsigned char* YSS = (unsigned char*)(ws + WS_YS + 160 * MiB);
    unsigned char* HNS = (unsigned char*)(ws + WS_YF); unsigned char* ACTS = (unsigned char*)(ws + WS_YF + 2 * MiB); unsigned char* W1S = (unsigned char*)(ws + WS_YF + 8 * MiB); unsigned char* W2S = (unsigned char*)(ws + WS_YF + 16 * MiB);

    if (IN(0)) REP(0) {
        LAS float* scr = (LAS float*)(lds + wave * 16896);
        constexpr int I_IN = (DM / 64) * (4096 / 64), I_ING = (DM / 128) * (4096 / 32), I_GLU = (SSMW / 64) * (4096 / 64), I_AO = (1024 / 64) * (DM / 64), I_OUT = (DM / 128) * (DM / 32);
        constexpr int I_E1 = MOE_MX ? (DM / 128) * (4096 / 32) : (DM / 64) * (4096 / 64), I_E2 = (MOE_MX == 1) ? (DFF / 128) * (DM / 32) : (DFF / 64) * (DM / 64);
        constexpr int NITEMS = I_IN + I_ING + I_GLU + I_AO + I_OUT + NEXP * (I_E1 + I_E2);
        for (int g = bx; g < NGRP; g += G) ssm_build_group(A, g, lds);
        for (int rnd = 0;; ++rnd) {
            if (tid == 0) MISC[16 + (rnd & 1)] = __hip_atomic_fetch_add(ctl + CW_Q0 + rep_, 16u, __ATOMIC_RELAXED, __HIP_MEMORY_SCOPE_AGENT);
            __syncthreads();
            const int base = (int)MISC[16 + (rnd & 1)]; if (base >= NITEMS) break;
          for (int sub = 0; sub < 2; ++sub) {
            const int it = base + sub * 8 + wave; if (it >= NITEMS) break;
            int r = it;
            if (r < I_IN) { transpose_item(A.in[I_WIN], DM, 4096, Wt_in, RmId(), scr, r, lane, INCOLS); continue; } r -= I_IN;
            if (r < I_ING) { transpose_item_q(A.in[I_WIN] + 4096, DM, 4096, WGQ, WGS, RmId(), scr, r, lane, INCOLS); continue; } r -= I_ING;
            if (r < I_GLU) { transpose_item(A.in[I_WGLU], SSMW, 4096, Wt_glu, RmGlu(), scr, r, lane); continue; } r -= I_GLU;
            if (r < I_AO) { transpose_item(A.in[I_WAO], 1024, DM, Wt_ao, RmId(), scr, r, lane); continue; } r -= I_AO;
            if (r < I_OUT) { transpose_item_q(A.in[I_WOUT], DM, DM, WOQ, WOS, RmId(), scr, r, lane); continue; } r -= I_OUT;
#if MOE_MX
            if (r < NEXP * I_E1) { const int e = r / I_E1; transpose_item_q(A.in[I_WE1] + (size_t)e * DM * 4096, DM, 4096, W1Q + (size_t)e * 4096 * DM, W1S + (size_t)e * 4096 * 64, RmE1(), scr, r % I_E1, lane); continue; } r -= NEXP * I_E1;
#if MOE_MX == 1
            { const int e = r / I_E2; transpose_item_q(A.in[I_WE2] + (size_t)e * DFF * DM, DFF, DM, W2Q + (size_t)e * DM * DFF, W2S + (size_t)e * DM * 64, RmId(), scr, r % I_E2, lane); }
#else
            { const int e = r / I_E2; transpose_item(A.in[I_WE2] + (size_t)e * DFF * DM, DFF, DM, Wt_e2 + (size_t)e * DM * DFF, RmId(), scr, r % I_E2, lane); }
#endif
#else
            if (r < NEXP * I_E1) { const int e = r / I_E1; transpose_item(A.in[I_WE1] + (size_t)e * DM * 4096, DM, 4096, Wt_e1 + (size_t)e * 4096 * DM, RmE1(), scr, r % I_E1, lane); continue; } r -= NEXP * I_E1;
            { const int e = r / I_E2; transpose_item(A.in[I_WE2] + (size_t)e * DFF * DM, DFF, DM, Wt_e2 + (size_t)e * DM * DFF, RmId(), scr, r % I_E2, lane); }
#endif
          }
        }
        for (int m = gw; m < MTOK + NMETA; m += NGW) {
            if (m < MTOK) rms_row_bf16(A.in[I_X] + (size_t)m * DM, A.in[I_GMIX], XN + (size_t)m * DM, lane, XNQ + (size_t)m * DM, XNS + (size_t)m * 64);
            else rms_row_bf16(A.in[I_META] + (size_t)(m - MTOK) * DM, A.in[I_GMIX], XNM + (size_t)(m - MTOK) * DM, lane);
        }
        for (int i = gw * 64 + lane; i < 128 * 64 * 8; i += NGW * 64) { const int ks = i >> 9, ln = (i >> 3) & 63, q = i & 7; const int e = ln & 31, k = ks * 16 + (ln >> 5) * 8 + q;
            const float w = A.in[I_WR][k * NEXP + e] * A.in[I_GMOE][k]; const unsigned hb = pk_bf16(w, 0.f) & 0xffffu; const float lo = w - __uint_as_float(hb << 16);
            WFH[i] = (bf16_t)hb; WFL[i] = (bf16_t)(pk_bf16(lo, 0.f) & 0xffffu); }
        for (int i = gw * 64 + lane; i < 2 * 48 * 128; i += NGW * 64) { const int w = i / (48 * 128), rem = i % (48 * 128); bf16_t* base = w ? VM : KM; *(u32x4*)(base + 16 * 1024 + rem * 8) = (u32x4){0u, 0u, 0u, 0u}; }
        if (BOTH(0)) GRID_BAR();
    }

    if (IN(1)) REP(1) {
        for (int ci = gw; ci < 3072; ci += NGW) {
            const int n = ci < 1024 ? ci : ci + 1024;
            float acc[16];
#pragma unroll
            for (int r = 0; r < 16; ++r) acc[r] = 0.f;
#pragma unroll
            for (int j = 0; j < 4; ++j) { float wv[8]; ld8bf(Wt_in + (size_t)n * DM + j * 512 + lane * 8, wv);
#pragma unroll
                for (int r = 0; r < 16; ++r) { float xv[8]; ld8bf(XNM + (size_t)r * DM + j * 512 + lane * 8, xv);
#pragma unroll
                    for (int q = 0; q < 8; ++q) acc[r] += wv[q] * xv[q]; } }
#pragma unroll
            for (int r = 0; r < 16; ++r) acc[r] = wave_sum(acc[r]);
            if (lane < 16) { float v = acc[0];
#pragma unroll
                for (int r = 1; r < 16; ++r) v = (lane == r) ? acc[r] : v;
                if (n < 1024) UM[lane * 1024 + n] = v;
                else if (n < 3072) KM[lane * 1024 + (n - 2048)] = (bf16_t)(pk_bf16(v, 0.f) & 0xffffu);
                else VM[lane * 1024 + (n - 3072)] = (bf16_t)(pk_bf16(v, 0.f) & 0xffffu); }
        }
        { pg8::RegOrder S; S.init(XN, Wt_in, DM, DM, MTOK, 4096, G, bx);
          EpiInProj E{UEXT, QB, KB, VB, GS, GA};
          pg8::gemm_run<EpiInProj, pg8::RegOrder, false>(lds, pg8::Dims{DM, DM, DM}, S, E); }
        { pg8::RegOrderMx S; S.init(XNQ, WGQ, DM / 2, DM / 2, MTOK, 4096, G, bx); S.sA = (const unsigned*)XNS; S.sB = (const unsigned*)WGS; S.nt = 16;
          EpiGates E{GS, GA};
          pg8::gemm_phase_mx<EpiGates, pg8::RegOrderMx, false>(lds, pg8::Dims{DM / 2, DM / 2, DM / 2}, S, E); }
        if (BOTH(1)) GRID_BAR();
    }

    auto norm_pass = [&](const int wv, const int NWV, LAS unsigned* nred) {
            float mq0 = 0.f, mq1 = 0.f, mk0 = 0.f, mk1 = 0.f;
#pragma unroll 2
            for (int m = wv; m < MTOK + NMETA; m += NWV) {
                const bool meta = m >= MTOK; float kk[16], qq[16];
                { float t0[8], t1[8]; const bf16_t* kp = meta ? KM + (size_t)(m - MTOK) * 1024 + lane * 16 : KB + (size_t)m * 1024 + lane * 16; ld8bf(kp, t0); ld8bf(kp + 8, t1);
#pragma unroll
                  for (int j = 0; j < 8; ++j) { kk[j] = t0[j]; kk[8 + j] = t1[j]; } }
                if (!meta) { float t0[8], t1[8]; const bf16_t* qp = QB + (size_t)m * 1024 + lane * 16; ld8bf(qp, t0); ld8bf(qp + 8, t1);
#pragma unroll
                  for (int j = 0; j < 8; ++j) { qq[j] = t0[j]; qq[8 + j] = t1[j]; } }
                else {
#pragma unroll
                  for (int j = 0; j < 16; ++j) qq[j] = 0.f; }
                float sk = 0.f, sq = 0.f;
#pragma unroll
                for (int j = 0; j < 16; ++j) { sk += kk[j] * kk[j]; sq += qq[j] * qq[j]; }
                sk += __shfl_xor(sk, 1); sk += __shfl_xor(sk, 2); sq += __shfl_xor(sq, 1); sq += __shfl_xor(sq, 2);
                if (meta) { mk0 = fmaxf(mk0, sk); mk1 = fmaxf(mk1, sk); }
                else if (m < SEQ) { mk0 = fmaxf(mk0, sk); mq0 = fmaxf(mq0, sq); } else { mk1 = fmaxf(mk1, sk); mq1 = fmaxf(mq1, sq); }
            }
            if ((lane & 3) == 0) { const int hc = lane >> 2;
                __hip_atomic_fetch_max(nred + hc, __float_as_uint(mq0), __ATOMIC_RELAXED, __HIP_MEMORY_SCOPE_WORKGROUP); __hip_atomic_fetch_max(nred + 16 + hc, __float_as_uint(mq1), __ATOMIC_RELAXED, __HIP_MEMORY_SCOPE_WORKGROUP);
                __hip_atomic_fetch_max(nred + 32 + hc, __float_as_uint(mk0), __ATOMIC_RELAXED, __HIP_MEMORY_SCOPE_WORKGROUP); __hip_atomic_fetch_max(nred + 48 + hc, __float_as_uint(mk1), __ATOMIC_RELAXED, __HIP_MEMORY_SCOPE_WORKGROUP); }

    };
    const bool norms_in_p2 = G > 2 * NGRP;
    if (IN(2)) REP(2) {
#if NAIVE_SSM
        float* YF = (float*)(ws + WS_YF);
        for (int c = gw; c < NB * NGRP; c += NGW) {
            const int g = c & 63, bb = c >> 6, p = lane;
            for (int d = 0; d < 2; ++d) {
                const float lr = A.in[d ? I_LRB : I_LRF][g * 64 + p], li = A.in[d ? I_LIB : I_LIF][g * 64 + p], dt = expf(A.in[d ? I_DTB : I_DTF][g]);
                const float mag = expf(lr * dt); float sn, cs; sincosf(li * dt, &sn, &cs); const float ar = mag * cs, ai = mag * sn;
                const float den = lr * lr + li * li, fr = ((ar - 1.0f) * lr + ai * li) / den, fi = (ai * lr - (ar - 1.0f) * li) / den;
                float br[16], bi[16], cr[16], ci[16];
#pragma unroll
                for (int i = 0; i < 16; ++i) { const float bre = A.in[d ? I_BRB : I_BRF][(g * 64 + p) * 16 + i], bim = A.in[d ? I_BIB : I_BIF][(g * 64 + p) * 16 + i];
                    br[i] = fr * bre - fi * bim; bi[i] = fr * bim + fi * bre; cr[i] = A.in[d ? I_CRB : I_CRF][(g * 16 + i) * 64 + p]; ci[i] = A.in[d ? I_CIB : I_CIF][(g * 16 + i) * 64 + p]; }
                float hr = 0.f, hi2 = 0.f;
                if (d == 0) for (int s = 0; s < 16; ++s) { float dr = 0.f, di = 0.f;
#pragma unroll
                    for (int i = 0; i < 16; ++i) { const float uv = UM[s * 1024 + g * 16 + i]; dr += uv * br[i]; di += uv * bi[i]; }
                    const float nr = ar * hr - ai * hi2 + dr, ni = ar * hi2 + ai * hr + di; hr = nr; hi2 = ni; }
                for (int tt = 0; tt < SEQ; ++tt) {
                    const int t = d ? (SEQ - 1 - tt) : tt;
                    float uv[16]; { float t0[8], t1[8]; const bf16_t* up = UEXT + ((size_t)(g * GROWS + bb * NCHUNK + (t >> 5)) * UEXT_LD + (t & 31) * 16); ld8bf(up, t0); ld8bf(up + 8, t1);
#pragma unroll
                        for (int i = 0; i < 8; ++i) { uv[i] = t0[i]; uv[8 + i] = t1[i]; } }
                    float dr = 0.f, di = 0.f;
#pragma unroll
                    for (int i = 0; i < 16; ++i) { dr += uv[i] * br[i]; di += uv[i] * bi[i]; }
                    const float nr = ar * hr - ai * hi2 + dr, ni = ar * hi2 + ai * hr + di; hr = nr; hi2 = ni;
                    float yv = 0.f;
#pragma unroll
                    for (int o = 0; o < 16; ++o) { const float s = wave_sum(hr * cr[o] - hi2 * ci[o]); yv = (lane == o) ? s : yv; }
                    if (lane < 16) {
                        const size_t m = (size_t)bb * SEQ + t;
                        if (d == 0) YF[m * SSMW + g * 16 + lane] = yv;
                        else { float uo = uv[0];
#pragma unroll
                            for (int o = 1; o < 16; ++o) uo = (lane == o) ? uv[o] : uo;
                            const float tot = YF[m * SSMW + g * 16 + lane] + yv + A.in[I_SSMD][g * 16 + lane] * uo;
                            YB[m * SSMW + g * 16 + lane] = (bf16_t)(pk_bf16(gelu_tanh(tot), 0.f) & 0xffffu); }
                    }
                }
            }
        }
#else
        pg8::SsmOrder S{(const char*)UEXT, (const char*)(ws + WS_WST), 1, 512, 256, G, vcu};
        EpiS1 E{SB};
        pg8::gemm_run<EpiS1, pg8::SsmOrder, false>(lds, pg8::Dims{UEXT_LD, 512, 512}, S, E);
        if (norms_in_p2 && vcu >= 2 * NGRP) {
            LAS unsigned* nred2 = (LAS unsigned*)lds;
            if (tid < 64) nred2[tid] = 0u;
            __syncthreads();
            norm_pass((vcu - 2 * NGRP) * NWAVES + wave, (G - 2 * NGRP) * NWAVES, nred2);
            __syncthreads();
            if (tid < 64 && nred2[tid]) atomicMax(ctl + CW_NRM + tid, nred2[tid]);
        }
#endif
        if (BOTH(2)) GRID_BAR();
    }

    if (IN(3)) REP(3) {
#if !NAIVE_SSM
        LAS unsigned* nred = (LAS unsigned*)lds;
        if (tid < 64) nred[tid] = 0u;
        __syncthreads();
        if (wave > 0 && !norms_in_p2) norm_pass((wave - 1) * G + vcu, 7 * G, nred);
        LAS float* SE = (LAS float*)(lds + 1024);
        for (int c = vcu; c < 2 * NB * NGRP; c += G) {
            const int g = c & 63, bb = (c >> 6) & 1, d = c >> 7, p = lane;
            const float lr = A.in[d ? I_LRB : I_LRF][g * 64 + p], li = A.in[d ? I_LIB : I_LIF][g * 64 + p], dt = expf(A.in[d ? I_DTB : I_DTF][g]);
            float sn, cs; const float mag32 = expf(lr * dt * 32.0f); sincosf(li * dt * 32.0f, &sn, &cs); const float a32r = mag32 * cs, a32i = mag32 * sn;
            const float* Sp = SB + ((size_t)(g * GROWS + bb * NCHUNK) * 256 + d * 128 + 2 * p);
            bf16_t* Cp = UEXT + ((size_t)(g * GROWS + bb * NCHUNK) * UEXT_LD + 512 + d * 128 + 2 * p);
            const int c0 = wave * 32;
            f32x2 sv[32];
#pragma unroll
            for (int k = 0; k < 32; ++k) { const int cc = d ? (NCHUNK - 1 - (c0 + k)) : (c0 + k); sv[k] = *(const f32x2*)(Sp + (size_t)cc * 256); }
            if (wave == 0) {
                float hr = 0.f, hi2 = 0.f;
                if (d == 0) {
                    const float mag = expf(lr * dt); sincosf(li * dt, &sn, &cs); const float ar = mag * cs, ai = mag * sn;
                    const float den = lr * lr + li * li, fr = ((ar - 1.0f) * lr + ai * li) / den, fi = (ai * lr - (ar - 1.0f) * li) / den;
                    float br[16], bi[16];
#pragma unroll
                    for (int i = 0; i < 16; ++i) { const float bre = A.in[I_BRF][(g * 64 + p) * 16 + i], bim = A.in[I_BIF][(g * 64 + p) * 16 + i]; br[i] = fr * bre - fi * bim; bi[i] = fr * bim + fi * bre; }
                    for (int s_ = 0; s_ < 16; ++s_) { float dr = 0.f, di = 0.f;
#pragma unroll
                        for (int i = 0; i < 16; ++i) { const float uv = UM[s_ * 1024 + g * 16 + i]; dr += uv * br[i]; di += uv * bi[i]; }
                        const float nr = ar * hr - ai * hi2 + dr, ni = ar * hi2 + ai * hr + di; hr = nr; hi2 = ni; }
                }
                SE[(8 * 64 + lane) * 2] = hr; SE[(8 * 64 + lane) * 2 + 1] = hi2;
            }
            f32x2 lp[32]; { float xr = 0.f, xi = 0.f;
#pragma unroll
                for (int k = 0; k < 32; ++k) { lp[k] = (f32x2){xr, xi}; const float nr = a32r * xr - a32i * xi + sv[k][0], ni = a32r * xi + a32i * xr + sv[k][1]; xr = nr; xi = ni; }
                SE[(wave * 64 + lane) * 2] = xr; SE[(wave * 64 + lane) * 2 + 1] = xi; }
            __syncthreads();
            float kr = a32r, ki = a32i;
#pragma unroll
            for (int q = 0; q < 5; ++q) { const float t_ = kr * kr - ki * ki; ki = 2.0f * kr * ki; kr = t_; }
            float cr = SE[(8 * 64 + lane) * 2], ci = SE[(8 * 64 + lane) * 2 + 1];
            for (int w = 0; w < wave; ++w) { const float er = SE[(w * 64 + lane) * 2], ei = SE[(w * 64 + lane) * 2 + 1]; const float nr = kr * cr - ki * ci + er, ni = kr * ci + ki * cr + ei; cr = nr; ci = ni; }
            { float pr = 1.f, pi_ = 0.f;
#pragma unroll
                for (int k = 0; k < 32; ++k) { const int cc = d ? (NCHUNK - 1 - (c0 + k)) : (c0 + k);
                    *(unsigned*)(Cp + (size_t)cc * UEXT_LD) = pk_bf16(lp[k][0] + (pr * cr - pi_ * ci), lp[k][1] + (pr * ci + pi_ * cr));
                    const float t_ = pr * a32r - pi_ * a32i; pi_ = pr * a32i + pi_ * a32r; pr = t_; } }
            __syncthreads();
        }
        __syncthreads();
        if (tid < 64 && nred[tid]) atomicMax(ctl + CW_NRM + tid, nred[tid]);
#endif
        if (BOTH(3)) GRID_BAR();
    }

    if (IN(4)) REP(4) {
#if !NAIVE_SSM
        pg8::SsmOrder S{(const char*)UEXT, (const char*)(ws + WS_BT3), 2, UEXT_LD, 512, G, vcu};
        EpiS3 E{YB};
        pg8::gemm_run<EpiS3, pg8::SsmOrder, false>(lds, pg8::Dims{UEXT_LD, UEXT_LD, UEXT_LD}, S, E);
#endif
        if (BOTH(4)) GRID_BAR();
    }

    if (IN(5)) REP(5) {
#if NAIVE_ATTN
        for (int it = bx * NTHREADS + tid; it < NB * NHC * SEQ; it += G * NTHREADS) {
            const int i = it & (SEQ - 1), hc = (it >> 13) & 15, bb = it >> 17, h = hc >> 1;
            const float nslope = -exp2f(-(float)(h + 1)) * LOG2E;
            float q[64], o[128];
#pragma unroll
            for (int d8 = 0; d8 < 8; ++d8) { float t[8]; ld8bf(QB + ((size_t)(bb * SEQ + i)) * 1024 + hc * 64 + d8 * 8, t);
#pragma unroll
                for (int j = 0; j < 8; ++j) q[d8 * 8 + j] = t[j]; }
#pragma unroll
            for (int j = 0; j < 128; ++j) o[j] = 0.f;
            float mx = -1e30f, l = 0.f;
            for (int jj = -NMETA; jj < SEQ; ++jj) {
                const bf16_t* kp = (jj < 0) ? KM + (size_t)(jj + NMETA) * 1024 + hc * 64 : KB + ((size_t)(bb * SEQ + jj)) * 1024 + hc * 64;
                const bf16_t* vp = (jj < 0) ? VM + (size_t)(jj + NMETA) * 1024 + h * 128 : VB + ((size_t)(bb * SEQ + jj)) * 1024 + h * 128;
                float s = 0.f;
#pragma unroll
                for (int d8 = 0; d8 < 8; ++d8) { float t[8]; ld8bf(kp + d8 * 8, t);
#pragma unroll
                    for (int j = 0; j < 8; ++j) s += q[d8 * 8 + j] * t[j]; }
                if (jj >= 0) s += nslope * fabsf((float)(i - jj));
                if (s > mx) { const float sc = exp2f(mx - s); l *= sc;
#pragma unroll
                    for (int j = 0; j < 128; ++j) o[j] *= sc;
                    mx = s; }
                const float pp = exp2f(s - mx); l += pp;
#pragma unroll
                for (int d8 = 0; d8 < 16; ++d8) { float t[8]; ld8bf(vp + d8 * 8, t);
#pragma unroll
                    for (int j = 0; j < 8; ++j) o[d8 * 8 + j] += pp * t[j]; }
            }
            const float rl = 1.0f / l;
#pragma unroll
            for (int d8 = 0; d8 < 16; ++d8) { float t[8];
#pragma unroll
                for (int j = 0; j < 8; ++j) t[j] = o[d8 * 8 + j] * rl;
                st8bf(OP + ((size_t)(bb * SEQ + i)) * 2048 + hc * 128 + d8 * 8, t); }
        }
#else
        for (int rnd = 0;; ++rnd) {
            if (tid == 0) MISC[20 + (rnd & 1)] = rnd == 0 ? (unsigned)bx : (unsigned)G + __hip_atomic_fetch_add(ctl + CW_AQ + rep_, 1u, __ATOMIC_RELAXED, __HIP_MEMORY_SCOPE_AGENT);
            __syncthreads();
            const int u = __builtin_amdgcn_readfirstlane((int)MISC[20 + (rnd & 1)]); if (u >= NB * NHC * 32) break;
            const int h = 7 - (u >> 7), bb = (u >> 6) & 1, c2 = (u >> 5) & 1, qb = u & 31, hc = 2 * h + c2, q0 = qb * 256;
            const float sl2 = exp2f(-(float)(h + 1)) * LOG2E, nslope = -sl2;
            const float qn2 = __uint_as_float(__hip_atomic_load(ctl + CW_NRM + bb * 16 + hc, __ATOMIC_RELAXED, __HIP_MEMORY_SCOPE_AGENT)), kn2 = __uint_as_float(__hip_atomic_load(ctl + CW_NRM + 32 + bb * 16 + hc, __ATOMIC_RELAXED, __HIP_MEMORY_SCOPE_AGENT));
            const float Mb = sqrtf(qn2) * sqrtf(kn2) * 1.001f; const float wf = fminf((160.0f + 2.0f * Mb) / sl2 + 1.0f, 16384.0f); const int Wd = (int)wf + 1;
            const int klo = (q0 - Wd) < 0 ? 0 : q0 - Wd, khi = (q0 + 255 + Wd) > SEQ - 1 ? SEQ - 1 : q0 + 255 + Wd;
            int t_lo = 1 + (klo >> 6), t_hi = 1 + (khi >> 6); int n = 2 + t_hi - t_lo;
            if ((n & 1) == 0) { if (t_lo > 1) --t_lo; else ++t_hi; ++n; }
            t_lo = __builtin_amdgcn_readfirstlane(t_lo); n = __builtin_amdgcn_readfirstlane(n);
            att::attn_unit(QB + ((size_t)(bb * SEQ + q0)) * 1024 + hc * 64, KB + (size_t)bb * SEQ * 1024 + hc * 64, VB + (size_t)bb * SEQ * 1024 + h * 128,
                           KM + hc * 64, VM + h * 128, OP + ((size_t)(bb * SEQ + q0)) * 2048 + hc * 128, q0, nslope, (char*)lds_raw, t_lo, n);
        }
#endif
        if (BOTH(5)) GRID_BAR();
    }

    if (IN(6)) REP(6) {
        float sa = A.in[I_LQ1][lane] * A.in[I_LK1][lane], sb = A.in[I_LQ2][lane] * A.in[I_LK2][lane];
        sa = wave_sum(sa); sb = wave_sum(sb);
        const float lam = expf(sa) - expf(sb) + 0.2f;
        const int h = lane >> 3, j0 = (lane & 7) * 16;
        float gsub[16];
#pragma unroll
        for (int j = 0; j < 16; ++j) gsub[j] = A.in[I_SUBG][j0 + j] * 0.8f;
        for (int m = gw; m < MTOK; m += NGW) {
            const bf16_t* p0 = OP + (size_t)m * 2048 + (2 * h) * 128 + j0; const bf16_t* p1 = p0 + 128;
            float a0[8], a1[8], b0[8], b1[8]; ld8bf(p0, a0); ld8bf(p0 + 8, a1); ld8bf(p1, b0); ld8bf(p1 + 8, b1);
            float dv[16]; float ss = 0.f;
#pragma unroll
            for (int j = 0; j < 8; ++j) { dv[j] = a0[j] - lam * b0[j]; dv[8 + j] = a1[j] - lam * b1[j]; }
#pragma unroll
            for (int j = 0; j < 16; ++j) ss += dv[j] * dv[j];
            ss += __shfl_xor(ss, 1); ss += __shfl_xor(ss, 2); ss += __shfl_xor(ss, 4);
            const float r = 1.0f / sqrtf(ss * (1.0f / 128.0f) + EPS);
            float y0[8], y1[8];
#pragma unroll
            for (int j = 0; j < 8; ++j) { y0[j] = dv[j] * r * gsub[j]; y1[j] = dv[8 + j] * r * gsub[8 + j]; }
            st8bf(OB + (size_t)m * 1024 + h * 128 + j0, y0); st8bf(OB + (size_t)m * 1024 + h * 128 + j0 + 8, y1);
        }
        if (BOTH(6)) GRID_BAR();
    }

    if (IN(7)) REP(7) {
        pg8::RegOrder S; S.init(OB, Wt_ao, 1024, 1024, MTOK, DM, G, bx);
        EpiAO E{GA, T2};
        pg8::gemm_run<EpiAO, pg8::RegOrder, false>(lds, pg8::Dims{1024, 1024, 1024}, S, E);
        if (BOTH(7)) GRID_BAR();
    }
    if (IN(8)) REP(8) {
        pg8::RegOrder S; S.init(YB, Wt_glu, SSMW, SSMW, MTOK, 4096, G, bx);
        EpiGLUQ E{GS, T2, MRGQ, MRGS};
        pg8::gemm_run<EpiGLUQ, pg8::RegOrder, false>(lds, pg8::Dims{SSMW, SSMW, SSMW}, S, E);
        if (BOTH(8)) GRID_BAR();
    }
    if (IN(9)) REP(9) {
        pg8::RegOrderMx S; S.init(MRGQ, WOQ, DM / 2, DM / 2, MTOK, DM, G, bx); S.sA = (const unsigned*)MRGS; S.sB = (const unsigned*)WOS; S.nt = 16;
        EpiOut E{A.in[I_X], H1B};
        pg8::gemm_phase_mx<EpiOut, pg8::RegOrderMx, false>(lds, pg8::Dims{DM / 2, DM / 2, DM / 2}, S, E);
        if (BOTH(9)) GRID_BAR();
    }

    if (IN(10)) REP(10) {
        const int rho = lane >> 4, l16 = lane & 15, kofs = 16 * l16 + 4 * rho;
        LAS float* PL = (LAS float*)lds;
        LAS unsigned* lcnt = (LAS unsigned*)(lds + 131072); LAS unsigned* lbase = lcnt + NEXP;
        if (tid < NEXP) lcnt[tid] = 0u;
        for (int rd = 0; rd * NGW < MTOK / 4; ++rd) {
            const int mg = rd * NGW + gw; const bool act = mg < MTOK / 4;
            u32x2 raw[4][8];
#pragma unroll
            for (int t = 0; t < 4; ++t)
#pragma unroll
                for (int j = 0; j < 8; ++j) raw[t][j] = *(const u32x2*)(H1B + (size_t)((act ? mg : 0) * 4 + t) * DM + j * 256 + kofs);
            {
                const int r32 = lane & 31, hi = lane >> 5; const int tokbase = (act ? mg - wave : 0) * 4;
                const bf16_t* hb = H1B + (size_t)(tokbase + r32) * DM + wave * 256 + hi * 8;
                const bf16_t* wfh = WFH + ((size_t)(wave * 16) * 64 + lane) * 8; const bf16_t* wfl = WFL + ((size_t)(wave * 16) * 64 + lane) * 8;
                f32x16 pacc = {};
#pragma unroll 8
                for (int ks = 0; ks < 16; ++ks) {
                    const bf16x8 bfr = *reinterpret_cast<const bf16x8*>(hb + ks * 16);
                    const bf16x8 ah = *reinterpret_cast<const bf16x8*>(wfh + (size_t)ks * 512), al = *reinterpret_cast<const bf16x8*>(wfl + (size_t)ks * 512);
                    pacc = __builtin_amdgcn_mfma_f32_32x32x16_bf16(ah, bfr, pacc, 0, 0, 0);
                    pacc = __builtin_amdgcn_mfma_f32_32x32x16_bf16(al, bfr, pacc, 0, 0, 0);
                }
#pragma unroll
                for (int q = 0; q < 4; ++q) *(LAS f32x4*)(PL + ((wave * 32 + r32) * 36 + 8 * q + 4 * hi)) = (f32x4){pacc[4 * q], pacc[4 * q + 1], pacc[4 * q + 2], pacc[4 * q + 3]};
            }
            float rr[4];
#pragma unroll
            for (int t = 0; t < 4; ++t) {
                float s = 0.f;
#pragma unroll
                for (int j = 0; j < 8; ++j) { const u32x2 hw = raw[t][j]; const float a0 = bf_lo(hw.x), a1 = bf_hi(hw.x), a2 = bf_lo(hw.y), a3 = bf_hi(hw.y); s += (a0 * a0 + a1 * a1) + (a2 * a2 + a3 * a3); }
                rr[t] = 1.0f / sqrtf(wave_sum(s) * (1.0f / DM) + EPS);
            }
            float mylg[4];
            { const int r32 = lane & 31, hi = lane >> 5;
                __syncthreads();
                const float be = A.in[I_BR][r32];
#pragma unroll
                for (int t = 0; t < 4; ++t) { float sm = 0.f;
#pragma unroll
                    for (int pw = 0; pw < 8; ++pw) sm += PL[(pw * 32 + 4 * wave + t) * 36 + r32];
                    mylg[t] = hi ? -3.0e38f : fmaf(rr[t], sm, be); }
            }
            int sel_e[4], sel_r[4]; float sel_g[4];
#pragma unroll
            for (int t = 0; t < 4; ++t) {
                float tv[4]; int ti[4]; float lg = mylg[t];
#pragma unroll
                for (int k = 0; k < 4; ++k) { float bv = lg; int bi = lane;
                    wave_argmax_dpp(bv, bi);
                    tv[k] = bv; ti[k] = bi; if (lane == bi) lg = -3.0e38f; }
                const float e1 = expf(tv[1] - tv[0]), e2 = expf(tv[2] - tv[0]), e3 = expf(tv[3] - tv[0]); const float inv = 1.0f / (1.0f + e1 + e2 + e3);
                sel_e[t] = lane == 0 ? ti[0] : lane == 1 ? ti[1] : lane == 2 ? ti[2] : ti[3];
                sel_g[t] = (lane == 0 ? 1.0f : lane == 1 ? e1 : lane == 2 ? e2 : e3) * inv;
                sel_r[t] = 0;
            }
            if (act && lane < 4) {
#pragma unroll
                for (int t = 0; t < 4; ++t) sel_r[t] = (int)__hip_atomic_fetch_add((LAS unsigned*)(lcnt + sel_e[t]), 1u, __ATOMIC_RELAXED, __HIP_MEMORY_SCOPE_WORKGROUP);
            }
            int ln2 = (int)threadIdx.x & 63; asm volatile("" : "+v"(ln2)); const int rho2 = ln2 >> 4, l16b = ln2 & 15, kofs2 = 16 * l16b + 4 * rho2;
            u32x2 rw[4][8]; f32x4 gg[8];
#pragma unroll
            for (int j = 0; j < 8; ++j) gg[j] = *(const f32x4*)(A.in[I_GMOE] + j * 256 + kofs2);
#pragma unroll
            for (int t = 0; t < 4; ++t)
#pragma unroll
                for (int j = 0; j < 8; ++j) rw[t][j] = *(const u32x2*)(H1B + (size_t)((act ? mg : 0) * 4 + t) * DM + j * 256 + kofs2);
            __syncthreads();
            if (tid < NEXP) { const unsigned c = lcnt[tid]; lbase[tid] = c ? __hip_atomic_fetch_add(ctl + CW_CNT + tid, c, __ATOMIC_RELAXED, __HIP_MEMORY_SCOPE_AGENT) : 0u; lcnt[tid] = 0u; }
            __syncthreads();
            if (act) {
            int drow[4], rkk[4];
#pragma unroll
            for (int t = 0; t < 4; ++t) { rkk[t] = (int)lbase[sel_e[t]] + sel_r[t]; drow[t] = sel_e[t] * 16384 + rkk[t]; }
            if (ln2 < 4) {
#pragma unroll
                for (int t = 0; t < 4; ++t) { const int a_ = (mg * 4 + t) * 4 + ln2; TOKR[a_] = (u32x2){(unsigned)sel_e[t] | ((unsigned)rkk[t] << 8), __float_as_uint(sel_g[t])}; }
            }
            int dq[4][4];
#pragma unroll
            for (int t = 0; t < 4; ++t)
#pragma unroll
                for (int q = 0; q < 4; ++q) dq[t][q] = __shfl(drow[t], q);
#pragma unroll
            for (int t = 0; t < 4; ++t) {
                f32x4 vt[8]; const float r = rr[t];
#pragma unroll
                for (int j = 0; j < 8; ++j) { const u32x2 hw = rw[t][j]; vt[j] = (f32x4){bf_lo(hw.x) * r * gg[j][0], bf_hi(hw.x) * r * gg[j][1], bf_lo(hw.y) * r * gg[j][2], bf_hi(hw.y) * r * gg[j][3]}; }
                unsigned wq[8], sbj[8];
#pragma unroll
                for (int j = 0; j < 8; ++j) {
                    float am = fmaxf(fmaxf(fabsf(vt[j][0]), fabsf(vt[j][1])), fmaxf(fabsf(vt[j][2]), fabsf(vt[j][3])));
                    am = fmaxf(am, __uint_as_float((unsigned)__builtin_amdgcn_update_dpp(0, (int)__float_as_uint(am), 0xB1, 0xF, 0xF, true)));
                    am = max_x16_x32(am);
                    sbj[j] = mx_scale_byte(am); wq[j] = fp8x4_scaled(vt[j][0], vt[j][1], vt[j][2], vt[j][3], __uint_as_float(sbj[j] << 23));
                }
                unsigned sbs2[2];
#pragma unroll
                for (int jj = 0; jj < 2; ++jj) {
                    const auto s01 = __builtin_amdgcn_permlane16_swap(wq[4 * jj], wq[4 * jj + 1], false, false); const auto s23 = __builtin_amdgcn_permlane16_swap(wq[4 * jj + 2], wq[4 * jj + 3], false, false);
                    const auto t02 = __builtin_amdgcn_permlane32_swap(s01[0], s23[0], false, false); const auto t13 = __builtin_amdgcn_permlane32_swap(s01[1], s23[1], false, false);
                    const u32x4 o = {t02[0], t13[0], t02[1], t13[1]};
                    const size_t co = (size_t)(4 * jj + rho2) * 256 + 16 * l16b;
                    sbs2[jj] = rho2 == 0 ? sbj[4 * jj] : rho2 == 1 ? sbj[4 * jj + 1] : rho2 == 2 ? sbj[4 * jj + 2] : sbj[4 * jj + 3];
#pragma unroll
                    for (int q = 0; q < 4; ++q) *(u32x4*)(HNQL + (size_t)dq[t][q] * DM + co) = o;
                }
                { const int srcl = 16 * ((ln2 >> 3) & 3) + 2 * (ln2 & 7); const unsigned c0_ = (unsigned)__shfl((int)sbs2[0], srcl), c1_ = (unsigned)__shfl((int)sbs2[1], srcl); const unsigned cb = (ln2 >> 5) ? c1_ : c0_;
#pragma unroll
                  for (int q = 0; q < 4; ++q) HNSL[(size_t)dq[t][q] * 64 + ln2] = (unsigned char)cb; }
            }
            }
        }
        __syncthreads();
        if (BOTH(10)) GRID_BAR();
    }

#define BUILD_TSTART() do { if (wave == 0) { const int l_ = (int)threadIdx.x & 63; const int c_ = (l_ < NEXP) ? (int)__hip_atomic_load(ctl + CW_CNT + l_, __ATOMIC_RELAXED, __HIP_MEMORY_SCOPE_AGENT) : 0; const int n_ = (c_ + 255) >> 8; int in_ = n_; \
        _Pragma("unroll") for (int o_ = 1; o_ < 32; o_ <<= 1) { const int t_ = __shfl_up(in_, o_); if (l_ >= o_) in_ += t_; } \
        if (l_ < NEXP) tstart[l_] = in_ - n_; if (l_ == NEXP - 1) tstart[NEXP] = in_; } __syncthreads(); } while (0)

#define SLOT_PASS() do { \
        for (int a = bx * NTHREADS + tid; a < MTOK * TOPK; a += G * NTHREADS) { \
            const u32x2 rec_ = TOKR[a]; const int e = (int)(rec_.x & 255u), slot = tstart[e] * 256 + (int)(rec_.x >> 8); \
            TOK_SLOT[a] = slot; SLOT_TOK[slot] = a >> 2; SLOT_GATE[slot] = __uint_as_float(rec_.y); \
        } \
        for (int a = bx * NTHREADS + tid; a < NEXP * 256; a += G * NTHREADS) { \
            const int e = a >> 8, k = a & 255; const int cnt = (int)__hip_atomic_load(ctl + CW_CNT + e, __ATOMIC_RELAXED, __HIP_MEMORY_SCOPE_AGENT); \
            const int slot = tstart[e] * 256 + cnt + k; \
            if (slot < tstart[e + 1] * 256) { SLOT_TOK[slot] = 0; SLOT_GATE[slot] = 0.f; } \
        } } while (0)

    if (IN(12)) REP(12) {
        BUILD_TSTART();
        SLOT_PASS();
#if MOE_MX
        pg8::MoeOrder S{(const char*)HNQL, (const char*)W1Q, nullptr, tstart, 16, DM / 2, 4096, DM / 2, G, vcu, (const unsigned*)HNSL, (const unsigned*)W1S, 16, 1};
#if MOE_MX == 1
        EpiMoe1Q E{A.in[I_BE1], ACTQ, ACTS};
        pg8::gemm_phase_mx<EpiMoe1Q, pg8::MoeOrder, false>(lds, pg8::Dims{DM / 2, DM / 2, DM / 2}, S, E);
#else
        EpiMoe1 E{A.in[I_BE1], ACT};
        pg8::gemm_phase_mx<EpiMoe1, pg8::MoeOrder, true>(lds, pg8::Dims{DM / 2, DM / 2, DM / 2}, S, E);
#endif
#else
        pg8::MoeOrder S{(const char*)HN, (const char*)Wt_e1, SLOT_TOK, tstart, 16, DM, 4096, DM, G, vcu, nullptr, nullptr, 0};
        EpiMoe1 E{A.in[I_BE1], ACT};
        pg8::gemm_run<EpiMoe1, pg8::MoeOrder, true>(lds, pg8::Dims{DM, DM, DM}, S, E);
#endif
        if (BOTH(12)) GRID_BAR();
    }
    if (IN(13)) REP(13) {
        BUILD_TSTART();
#if MOE_MX == 1
        pg8::MoeOrder S{(const char*)ACTQ, (const char*)W2Q, nullptr, tstart, 8, DFF / 2, DM, DFF / 2, G, vcu, (const unsigned*)ACTS, (const unsigned*)W2S, 16, 0};
        EpiMoe2Q E{A.in[I_BE2], SLOT_GATE, YSQ, YSS};
        pg8::gemm_phase_mx<EpiMoe2Q, pg8::MoeOrder, false>(lds, pg8::Dims{DFF / 2, DFF / 2, DFF / 2}, S, E);
#else
        pg8::MoeOrder S{(const char*)ACT, (const char*)Wt_e2, nullptr, tstart, 8, DFF, DM, DFF, G, vcu, nullptr, nullptr, 0};
        EpiMoe2 E{A.in[I_BE2], SLOT_GATE, YS};
        pg8::gemm_run<EpiMoe2, pg8::MoeOrder, false>(lds, pg8::Dims{DFF, DFF, DFF}, S, E);
#endif
        if (BOTH(13)) GRID_BAR();
    }

    if (IN(14)) REP(14) {
        const int rho = lane >> 4, l16 = lane & 15, kofs = 16 * l16 + 4 * rho;
        for (int m = gw; m < MTOK; m += NGW) {
            const bf16_t* hrow = H1B + (size_t)m * DM; float* orow = A.out + (size_t)m * DM;
            const i32x4_t sl4 = *(const i32x4_t*)(TOK_SLOT + m * 4);
            f32x4 v[8];
#pragma unroll
            for (int j = 0; j < 8; ++j) { const u32x2 hw = *(const u32x2*)(hrow + j * 256 + kofs); v[j] = (f32x4){bf_lo(hw.x), bf_hi(hw.x), bf_lo(hw.y), bf_hi(hw.y)}; }
#pragma unroll
            for (int q = 0; q < 4; ++q) { const size_t sl = (size_t)sl4[q];
                const u32x2 sc = *(const u32x2*)(YSS + sl * 64 + (l16 >> 1) * 8);
#pragma unroll
                for (int jj = 0; jj < 2; ++jj) { const u32x4 y = *(const u32x4*)(YSQ + sl * DM + (size_t)(4 * jj + rho) * 256 + 16 * l16);
                    const auto s01 = __builtin_amdgcn_permlane16_swap(y.x, y.y, false, false); const auto s23 = __builtin_amdgcn_permlane16_swap(y.z, y.w, false, false);
                    const auto t02 = __builtin_amdgcn_permlane32_swap(s01[0], s23[0], false, false); const auto t13 = __builtin_amdgcn_permlane32_swap(s01[1], s23[1], false, false);
                    const unsigned w_[4] = {t02[0], t13[0], t02[1], t13[1]}; const unsigned sw = jj ? sc.y : sc.x;
#pragma unroll
                    for (int i = 0; i < 4; ++i) { const int j = 4 * jj + i; const float sc_ = __uint_as_float(((sw >> (8 * i)) & 0xffu) << 23);
                        const f32x2 lo_ = __builtin_amdgcn_cvt_pk_f32_fp8((int)w_[i], false), hi_ = __builtin_amdgcn_cvt_pk_f32_fp8((int)w_[i], true);
                        v[j][0] = fmaf(lo_[0], sc_, v[j][0]); v[j][1] = fmaf(lo_[1], sc_, v[j][1]); v[j][2] = fmaf(hi_[0], sc_, v[j][2]); v[j][3] = fmaf(hi_[1], sc_, v[j][3]); }
                } }
            float s = 0.f;
#pragma unroll
            for (int j = 0; j < 8; ++j) s += (v[j][0] * v[j][0] + v[j][1] * v[j][1]) + (v[j][2] * v[j][2] + v[j][3] * v[j][3]);
            const float r = 1.0f / sqrtf(wave_sum(s) * (1.0f / DM) + EPS);
#pragma unroll
            for (int j = 0; j < 8; ++j) { const f32x4 g = *(const f32x4*)(A.in[I_GFIN] + j * 256 + kofs);
                *(f32x4*)(orow + j * 256 + kofs) = (f32x4){v[j][0] * r * g[0], v[j][1] * r * g[1], v[j][2] * r * g[2], v[j][3] * r * g[3]}; }
        }
    }
#undef IN
#undef BOTH
}

extern "C" void kernel_launch(void* const* d_in, const int* in_sizes, int n_in, void* d_out, int out_size, void* d_ws, size_t ws_size, hipStream_t stream) {
    static int grid = 0;
    if (grid == 0) {
        if (n_in != 35 || in_sizes[0] != MTOK * DM || out_size != MTOK * DM || ws_size < WS_END) { fprintf(stderr, "kernel_launch: unexpected shapes (n_in %d, in0 %d, out %d, ws %zu)\n", n_in, n_in > 0 ? in_sizes[0] : -1, out_size, ws_size); grid = -1; return; }
        int dev = 0, cus = 0;
        if (hipGetDevice(&dev) != hipSuccess || hipDeviceGetAttribute(&cus, hipDeviceAttributeMultiprocessorCount, dev) != hipSuccess) { grid = -1; return; }
        if (hipFuncSetAttribute((const void*)mk_fwd, hipFuncAttributeMaxDynamicSharedMemorySize, LDS_BYTES) != hipSuccess) { fprintf(stderr, "kernel_launch: hipFuncSetAttribute failed\n"); grid = -1; return; }
        int per_cu = 0;
        if (hipOccupancyMaxActiveBlocksPerMultiprocessor(&per_cu, (const void*)mk_fwd, NTHREADS, LDS_BYTES) != hipSuccess || per_cu < 1) fprintf(stderr, "kernel_launch: occupancy query says %d\n", per_cu);
        (void)hipGetLastError();
        grid = cus;
    }
    if (grid < 0) return;
    (void)hipMemsetAsync((char*)d_ws + WS_CTL, 0, CTL_ZERO_BYTES, stream);
    Args a{};
    for (int i = 0; i < 35; ++i) a.in[i] = (const float*)d_in[i];
    a.out = (float*)d_out; a.ws = (unsigned char*)d_ws;
#if MK_FUSED
    a.ph_lo = 0; a.ph_hi = NPHASE;
    hipLaunchKernelGGL(mk_fwd, dim3(grid), dim3(NTHREADS), LDS_BYTES, stream, a);
#else
    for (int p = 0; p < NPHASE; ++p) { a.ph_lo = p; a.ph_hi = p + 1; hipLaunchKernelGGL(mk_fwd, dim3(grid), dim3(NTHREADS), LDS_BYTES, stream, a); }
#endif
    const hipError_t le = hipPeekAtLastError();
    if (le != hipSuccess) fprintf(stderr, "kernel_launch: launch failed: %s\n", hipGetErrorName(le));
}
```

```cpp
#include <hip/hip_runtime.h>
#include <cstdio>
#include <cstdint>

#ifndef MK_FUSED
#define MK_FUSED 1
#endif
#ifndef DBL_MASK
#define DBL_MASK 0
#endif
#ifndef MOE_MX
#define MOE_MX 1
#endif
#ifndef NAIVE_GEMM
#define NAIVE_GEMM 0
#endif
#ifndef NAIVE_ATTN
#define NAIVE_ATTN 0
#endif
#ifndef NAIVE_SSM
#define NAIVE_SSM 0
#endif

#define LAS __attribute__((address_space(3)))
#define GAS __attribute__((address_space(1)))
typedef unsigned short bf16_t;
typedef short bf16x8 __attribute__((ext_vector_type(8)));
typedef short s16x4 __attribute__((ext_vector_type(4)));
typedef float f32x2 __attribute__((ext_vector_type(2)));
typedef float f32x4 __attribute__((ext_vector_type(4)));
typedef float f32x16 __attribute__((ext_vector_type(16)));
typedef unsigned u32x2 __attribute__((ext_vector_type(2)));
typedef unsigned u32x4 __attribute__((ext_vector_type(4)));
typedef int i32x4_t __attribute__((ext_vector_type(4)));
typedef __bf16 bf16x2_t __attribute__((ext_vector_type(2)));

constexpr int NB = 2, SEQ = 8192, DM = 2048, MTOK = NB * SEQ, NMETA = 16;
constexpr int SSMW = 1024, NGRP = 64, GSZ = 16, NST = 64, CHUNK = 32, NCHUNK = SEQ / CHUNK  , GROWS = NB * NCHUNK  , UEXT_LD = 768;
constexpr int NHEAD = 8, DH = 64, DV = 128, NHC = 16;
constexpr int NEXP = 32, TOPK = 4, DFF = 2048;
constexpr int INCOLS = 8192;
constexpr float EPS = 1e-5f;
constexpr float LOG2E = 1.4426950408889634f;
constexpr float QSCALE = 0.125f * LOG2E;
constexpr int MAXSLOT = MTOK * TOPK + NEXP * 256;

constexpr size_t MiB = 1u << 20;
constexpr size_t WS_CTL = 0, CTL_ZERO_BYTES = 1 * MiB;
constexpr size_t WS_MISC = 1 * MiB;
constexpr size_t MISC_XNM = 4096, MISC_UM = 128 * 1024, MISC_KM = 256 * 1024, MISC_VM = 384 * 1024, MISC_WRT = 512 * 1024;
constexpr size_t WS_WIN = 16 * MiB, WS_WGLU = 48 * MiB, WS_WAO = 56 * MiB, WS_WOUT = 60 * MiB, WS_BT3 = 68 * MiB, WS_WST = 116 * MiB;
constexpr size_t WS_XN = 132 * MiB, WS_UEXT = 196 * MiB, WS_Q = 244 * MiB, WS_K = 276 * MiB, WS_V = 308 * MiB, WS_GS = 340 * MiB, WS_GA = 404 * MiB;
constexpr size_t WS_S = 468 * MiB, WS_Y = 500 * MiB, WS_OP = 532 * MiB, WS_O = 660 * MiB, WS_T2 = 692 * MiB, WS_MRG = 756 * MiB, WS_HN = 820 * MiB;
constexpr size_t WS_ROUTE = 884 * MiB;
constexpr size_t RT_E = 0, RT_RANK = 256 * 1024, RT_GATE = 512 * 1024, RT_SLOT = 768 * 1024, RT_STOK = 1024 * 1024, RT_SGATE = 1536 * 1024;
constexpr size_t WS_ACT = 888 * MiB, WS_YS = 1192 * MiB, WS_WE1 = 1496 * MiB, WS_WE2 = 2008 * MiB, WS_YF = 2264 * MiB, WS_XNQ = 2328 * MiB  , WS_XNS = 2360 * MiB  , WS_WGQ = 2362 * MiB  , WS_WGS = 2370 * MiB, WS_HNL = 2372 * MiB  , WS_HNLS = 3396 * MiB  , WS_END = 3428 * MiB;
constexpr int CW_TMO = 0, CW_CNT = 64  , CW_Q0 = 128  , CW_AQ = 160  , CW_NRM = 192  , CW_BAR = 4096;

constexpr int RING_BYTES = 139264  , LDSCTL_OFF = RING_BYTES, MISC_OFF = LDSCTL_OFF + 320, LDS_BYTES = 147456;
static_assert(MISC_OFF + 128 <= LDS_BYTES && (2 * 33 * 64 * 2 + 2 * 64 * 16 * 2 + 2 * 16 * 64 * 2 + 2 * 32 * 16 * 16) * 4 <= RING_BYTES && 8 * 16896 <= RING_BYTES, "LDS map");
constexpr int NWAVES = 8, NTHREADS = 512;

__device__ __forceinline__ unsigned pk_bf16(float lo, float hi) { f32x2 v = {lo, hi}; bf16x2_t b = __builtin_convertvector(v, bf16x2_t); return __builtin_bit_cast(unsigned, b); }
__device__ __forceinline__ float bf_lo(unsigned w) { return __uint_as_float(w << 16); }
__device__ __forceinline__ float bf_hi(unsigned w) { return __uint_as_float(w & 0xffff0000u); }
__device__ __forceinline__ float bf2f(bf16_t b) { return __uint_as_float(((unsigned)b) << 16); }
__device__ __forceinline__ void unpack8(const u32x4 w, float (&f)[8]) { f[0] = bf_lo(w.x); f[1] = bf_hi(w.x); f[2] = bf_lo(w.y); f[3] = bf_hi(w.y); f[4] = bf_lo(w.z); f[5] = bf_hi(w.z); f[6] = bf_lo(w.w); f[7] = bf_hi(w.w); }
__device__ __forceinline__ u32x4 pack8(const float (&f)[8]) { u32x4 w; w.x = pk_bf16(f[0], f[1]); w.y = pk_bf16(f[2], f[3]); w.z = pk_bf16(f[4], f[5]); w.w = pk_bf16(f[6], f[7]); return w; }
__device__ __forceinline__ void ld8bf(const bf16_t* p, float (&f)[8]) { unpack8(*(const u32x4*)p, f); }
__device__ __forceinline__ void st8bf(bf16_t* p, const float (&f)[8]) { *(u32x4*)p = pack8(f); }
__device__ __forceinline__ float sigmoidf_fast(float x) { return __builtin_amdgcn_rcpf(1.0f + __builtin_amdgcn_exp2f(-x * LOG2E)); }
__device__ __forceinline__ float wave_sum_dpp(float v);
__device__ __forceinline__ float wave_sum(float v) { return wave_sum_dpp(v); }
__device__ __forceinline__ unsigned mx_scale_byte(float amax) { const int f = (int)((__float_as_uint(amax) >> 23) & 0xffu) - 7; return (unsigned)(f < 0 ? 0 : f); }
__device__ __forceinline__ float mx_inv_scale(unsigned sbyte) { return __uint_as_float((254u - sbyte) << 23); }
__device__ __forceinline__ int mx_phys(int kk) { return kk; }
__device__ __forceinline__ unsigned fp8x4(float a, float b, float c, float d) { int w = 0; w = __builtin_amdgcn_cvt_pk_fp8_f32(a, b, w, false); w = __builtin_amdgcn_cvt_pk_fp8_f32(c, d, w, true); return (unsigned)w; }
__device__ __forceinline__ float max_x16_x32(float v) {
    { auto r = __builtin_amdgcn_permlane16_swap(__float_as_uint(v), __float_as_uint(v), false, false); v = fmaxf(__uint_as_float(r[0]), __uint_as_float(r[1])); }
    { auto r = __builtin_amdgcn_permlane32_swap(__float_as_uint(v), __float_as_uint(v), false, false); v = fmaxf(__uint_as_float(r[0]), __uint_as_float(r[1])); }
    return v;
}
template <int CTRL> __device__ __forceinline__ float dpp_f(float v) { return __uint_as_float((unsigned)__builtin_amdgcn_update_dpp(0, (int)__float_as_uint(v), CTRL, 0xF, 0xF, true)); }
template <int CTRL> __device__ __forceinline__ int dpp_i(int v) { return __builtin_amdgcn_update_dpp(0, v, CTRL, 0xF, 0xF, true); }
__device__ __forceinline__ float wave_sum_dpp(float v) {
    v += dpp_f<0xB1>(v); v += dpp_f<0x4E>(v); v += dpp_f<0x141>(v); v += dpp_f<0x140>(v);
    { auto r = __builtin_amdgcn_permlane16_swap(__float_as_uint(v), __float_as_uint(v), false, false); v = __uint_as_float(r[0]) + __uint_as_float(r[1]); }
    { auto r = __builtin_amdgcn_permlane32_swap(__float_as_uint(v), __float_as_uint(v), false, false); v = __uint_as_float(r[0]) + __uint_as_float(r[1]); }
    return v;
}
__device__ __forceinline__ void amax_step(float& bv, int& bi, float ov, int oi) { const bool tk = (ov > bv) || (ov == bv && oi < bi); bv = tk ? ov : bv; bi = tk ? oi : bi; }
__device__ __forceinline__ void wave_argmax_dpp(float& bv, int& bi) {
    amax_step(bv, bi, dpp_f<0xB1>(bv), dpp_i<0xB1>(bi)); amax_step(bv, bi, dpp_f<0x4E>(bv), dpp_i<0x4E>(bi));
    amax_step(bv, bi, dpp_f<0x141>(bv), dpp_i<0x141>(bi)); amax_step(bv, bi, dpp_f<0x140>(bv), dpp_i<0x140>(bi));
    { auto rv = __builtin_amdgcn_permlane16_swap(__float_as_uint(bv), __float_as_uint(bv), false, false); auto ri = __builtin_amdgcn_permlane16_swap((unsigned)bi, (unsigned)bi, false, false);
      bv = __uint_as_float(rv[0]); bi = (int)ri[0]; amax_step(bv, bi, __uint_as_float(rv[1]), (int)ri[1]); }
    { auto rv = __builtin_amdgcn_permlane32_swap(__float_as_uint(bv), __float_as_uint(bv), false, false); auto ri = __builtin_amdgcn_permlane32_swap((unsigned)bi, (unsigned)bi, false, false);
      bv = __uint_as_float(rv[0]); bi = (int)ri[0]; amax_step(bv, bi, __uint_as_float(rv[1]), (int)ri[1]); }
}
typedef short s16x2_t __attribute__((ext_vector_type(2)));
__device__ __forceinline__ unsigned fp8x4_scaled(float a, float b, float c, float d, float scale) {
    s16x2_t w = {0, 0}; w = __builtin_amdgcn_cvt_scalef32_pk_fp8_f32(w, a, b, scale, false); w = __builtin_amdgcn_cvt_scalef32_pk_fp8_f32(w, c, d, scale, true); return __builtin_bit_cast(unsigned, w); }
#define LDS_WAIT() asm volatile("s_waitcnt lgkmcnt(0)" ::: "memory")
#define VM_WAIT() asm volatile("s_waitcnt vmcnt(0)" ::: "memory")

namespace pg8 {
constexpr int BM = 256, BK = 64, HALF = 128, HTB = HALF * BK * 2, STAGE_BYTES = 8 * HTB, NXCD = 8, WGM = 8;
__host__ __device__ __forceinline__ int lds_byte(int r, int c) { const int st = (r >> 4) * 2 + (c >> 5), rr = r & 15, cc = c & 31, ob = rr * 64 + cc * 2; return st * 1024 + (ob ^ (((ob >> 9) & 1) << 5)); }
__host__ __device__ __forceinline__ void stage_rc(int b, int& R, int& C) { const int st = b / 1024, sb = b % 1024, swz = sb ^ (((sb >> 9) & 1) << 5); R = (st >> 1) * 16 + swz / 64; C = (st & 1) * 32 + (swz % 64) / 2; }
__host__ __device__ __forceinline__ int perm32(int rho) { const int n = rho >> 4, i = rho & 15; return 8 * (i >> 2) + 4 * n + (i & 3); }

struct Unit { int pm, pn, aux; };
struct Dims { int lda, ldb, K; };

struct NoCtx {};
template <class Epi> __device__ __forceinline__ auto epi_prep(const Epi& E, const Unit& u, int wr, int cg, int fr, int) -> decltype(E.prep(u, wr, cg, fr)) { return E.prep(u, wr, cg, fr); }
template <class Epi> __device__ __forceinline__ NoCtx epi_prep(const Epi&, const Unit&, int, int, int, long) { return NoCtx{}; }
template <class Epi, class C> __device__ __forceinline__ auto epi_store(const Epi& E, const Unit& u, int r, int cg, const float (&a)[8], const float (&b)[8], const C& c, int i, int) -> decltype(E.store8(u, r, cg, a, b, c, i)) { E.store8(u, r, cg, a, b, c, i); }
template <class Epi, class C> __device__ __forceinline__ void epi_store(const Epi& E, const Unit& u, int r, int cg, const float (&a)[8], const float (&b)[8], const C&, int, long) { E.store8(u, r, cg, a, b); }
template <class Epi>
__device__ __forceinline__ void epi_run(const Epi& E, const f32x4 (&acc)[2][2][4][2], const Unit& u, int wr, int wc, int fr, int fq) {
    asm volatile("" : "+v"(fr), "+v"(fq));
    const int cg = 4 * wc + fq;
    const auto ctx = epi_prep(E, u, wr, cg, fr, 0);
    if constexpr (Epi::PAIR) {
#pragma unroll
        for (int ai = 0; ai < 2; ++ai)
#pragma unroll
            for (int mp = 0; mp < 2; ++mp) {
                const int r = ai * HALF + wr * 64 + mp * 32 + fr;
                float a0[8], b0[8], a1[8], b1[8];
#pragma unroll
                for (int j = 0; j < 4; ++j) { a0[j] = acc[ai][0][2 * mp][0][j]; a0[4 + j] = acc[ai][0][2 * mp][1][j]; b0[j] = acc[ai][1][2 * mp][0][j]; b0[4 + j] = acc[ai][1][2 * mp][1][j];
                    a1[j] = acc[ai][0][2 * mp + 1][0][j]; a1[4 + j] = acc[ai][0][2 * mp + 1][1][j]; b1[j] = acc[ai][1][2 * mp + 1][0][j]; b1[4 + j] = acc[ai][1][2 * mp + 1][1][j]; }
                E.store_pair(u, r, cg, a0, b0, a1, b1, ctx, ai * 4 + 2 * mp);
            }
    } else {
#pragma unroll
    for (int ai = 0; ai < 2; ++ai)
#pragma unroll
        for (int m = 0; m < 4; ++m) {
            const int r = ai * HALF + wr * 64 + m * 16 + fr;
            float a[8], b[8];
#pragma unroll
            for (int j = 0; j < 4; ++j) { a[j] = acc[ai][0][m][0][j]; a[4 + j] = acc[ai][0][m][1][j]; b[j] = acc[ai][1][m][0][j]; b[4 + j] = acc[ai][1][m][1][j]; }
            epi_store(E, u, r, cg, a, b, ctx, ai * 4 + m, 0);
        }
    }
}
__device__ __forceinline__ u32x4 pair_swap(const u32x2 o0, const u32x2 o1) {
    const auto X = __builtin_amdgcn_permlane16_swap(o0.x, o1.x, false, false); const auto Y = __builtin_amdgcn_permlane16_swap(o0.y, o1.y, false, false);
    return (u32x4){X[0], Y[0], X[1], Y[1]};
}

template <class Epi, class Sched, bool GATHER>
__device__ __forceinline__ void gemm_phase(LAS unsigned char* lds, const Dims g, const Sched& S, const Epi& E) {
    const int tid = threadIdx.x, wid = __builtin_amdgcn_readfirstlane(tid >> 6), lane = tid & 63, wr = wid >> 2, wc = wid & 3, fr = lane & 15, fq = lane >> 4;
    const int K = g.K, nt = K / BK;
    int Rr[2]; unsigned cofs[2], voffB[2];
#pragma unroll
    for (int i = 0; i < 2; ++i) { int R, C; stage_rc(tid * 16 + i * 8192, R, C); const int Rb = (R & ~31) + perm32(R & 31);
        Rr[i] = R; cofs[i] = (unsigned)C * 2u; voffB[i] = (unsigned)(Rb * g.ldb + C) * 2u; }
    const size_t kstep = (size_t)(BK * 2);
    const size_t hstepB = (size_t)HALF * g.ldb * 2;
    const unsigned ldsw = (unsigned)wid * 1024u;
    const int aoff = lds_byte(wr * 64 + fr, fq * 8), boff = lds_byte(wc * 32 + fr, fq * 8);
    const unsigned ldab = (unsigned)g.lda * 2u;
#define PG8_SA(b, h) (((b) * 2 + (h)) * HTB)
#define PG8_SB(b, h) ((4 + (b) * 2 + (h)) * HTB)
#define PG8_STB(bufoff, gbase) do { _Pragma("unroll") for (int _i = 0; _i < 2; ++_i) \
        __builtin_amdgcn_global_load_lds((const unsigned*)((const char*)(gbase) + voffB[_i]), (LAS unsigned*)(lds + (bufoff) + ldsw + _i * 8192), 16, 0, 0); } while (0)
#define PG8_STA(bufoff, gbase, V, h) do { _Pragma("unroll") for (int _i = 0; _i < 2; ++_i) \
        __builtin_amdgcn_global_load_lds((const unsigned*)((const char*)(gbase) + (V)[h][_i]), (LAS unsigned*)(lds + (bufoff) + ldsw + _i * 8192), 16, 0, 0); } while (0)
#define PG8_LDV(u_, V) do { if constexpr (GATHER) { const int* rw_ = S.rows(u_); \
        _Pragma("unroll") for (int h_ = 0; h_ < 2; ++h_) _Pragma("unroll") for (int i_ = 0; i_ < 2; ++i_) (V)[h_][i_] = (unsigned)rw_[h_ * HALF + Rr[i_]] * ldab + cofs[i_]; } \
        else { _Pragma("unroll") for (int h_ = 0; h_ < 2; ++h_) _Pragma("unroll") for (int i_ = 0; i_ < 2; ++i_) (V)[h_][i_] = (unsigned)(h_ * HALF + Rr[i_]) * ldab + cofs[i_]; } } while (0)
#define PG8_LDA(dst, b, h) do { _Pragma("unroll") for (int m = 0; m < 4; ++m) _Pragma("unroll") for (int k = 0; k < 2; ++k) dst[m][k] = *(const LAS bf16x8*)(lds + PG8_SA(b, h) + aoff + m * 2048 + k * 1024); } while (0)
#define PG8_LDB(dst, b, h) do { _Pragma("unroll") for (int n = 0; n < 2; ++n) _Pragma("unroll") for (int k = 0; k < 2; ++k) dst[n][k] = *(const LAS bf16x8*)(lds + PG8_SB(b, h) + boff + n * 2048 + k * 1024); } while (0)
#define PG8_MMA(ai, bj, At, Bt) do { __builtin_amdgcn_s_setprio(1); _Pragma("unroll") for (int m = 0; m < 4; ++m) _Pragma("unroll") for (int n = 0; n < 2; ++n) _Pragma("unroll") for (int k = 0; k < 2; ++k) \
        acc[ai][bj][m][n] = __builtin_amdgcn_mfma_f32_16x16x32_bf16(Bt[n][k], At[m][k], acc[ai][bj][m][n], 0, 0, 0); __builtin_amdgcn_s_setprio(0); } while (0)
#define PG8_WAIT_V(n) asm volatile("s_waitcnt vmcnt(" #n ")" ::: "memory")
#define PG8_WAIT_L(n) asm volatile("s_waitcnt lgkmcnt(" #n ")" ::: "memory")
#define PG8_BAR __builtin_amdgcn_s_barrier()
#define PG8_SCHED __builtin_amdgcn_sched_barrier(0)
    Unit cur, nxt; int ui = 0;
    if (!S.next(0, cur)) return;
    f32x4 acc[2][2][4][2];
#pragma unroll
    for (int a = 0; a < 2; ++a)
#pragma unroll
        for (int b = 0; b < 2; ++b)
#pragma unroll
            for (int m = 0; m < 4; ++m)
#pragma unroll
                for (int n = 0; n < 2; ++n) acc[a][b][m][n] = (f32x4){0.f, 0.f, 0.f, 0.f};
    bf16x8 At[4][2], B0[2][2], B1[2][2];
    unsigned vAc[2][2], vAn[2][2];
    const char* cA = S.abase(cur); const char* cB = S.bbase(cur);
    PG8_LDV(cur, vAc);
    PG8_STB(PG8_SB(0, 0), cB); PG8_STB(PG8_SB(0, 1), cB + hstepB); PG8_STA(PG8_SA(0, 0), cA, vAc, 0); PG8_STA(PG8_SA(0, 1), cA, vAc, 1);
    if (wr == 1) PG8_BAR;
    PG8_WAIT_V(2); PG8_BAR;
    PG8_STB(PG8_SB(1, 0), cB + kstep); PG8_STA(PG8_SA(1, 0), cA + kstep, vAc, 0); PG8_STB(PG8_SB(1, 1), cB + hstepB + kstep);
    PG8_WAIT_V(6); PG8_BAR;
    for (;;) {
        const bool has_next = S.next(ui + 1, nxt);
        const char* nA = has_next ? S.abase(nxt) : cA; const char* nB = has_next ? S.bbase(nxt) : cB;
        if (has_next) { PG8_LDV(nxt, vAn); }
        else {
#pragma unroll
            for (int h = 0; h < 2; ++h)
#pragma unroll
                for (int i = 0; i < 2; ++i) vAn[h][i] = vAc[h][i];
        }
        for (int t = 0; t < nt; t += 2) {
            const bool last = (t == nt - 2);
            const char* a1 = cA + (size_t)(t + 1) * kstep;
            const char* a2 = last ? nA : cA + (size_t)(t + 2) * kstep; const char* b2 = last ? nB : cB + (size_t)(t + 2) * kstep;
            const char* a3 = a2 + kstep; const char* b3 = b2 + kstep;
            unsigned v2[2][2];
#pragma unroll
            for (int h = 0; h < 2; ++h)
#pragma unroll
                for (int i = 0; i < 2; ++i) v2[h][i] = last ? vAn[h][i] : vAc[h][i];
            PG8_LDB(B0, 0, 0); PG8_LDB(B1, 0, 1); PG8_SCHED; PG8_LDA(At, 0, 0); PG8_STA(PG8_SA(1, 1), a1, vAc, 1);
            PG8_WAIT_V(8); PG8_WAIT_L(0); PG8_BAR; PG8_MMA(0, 0, At, B0); PG8_MMA(0, 1, At, B1); PG8_BAR; PG8_SCHED;
            PG8_LDA(At, 0, 1); PG8_STB(PG8_SB(0, 0), b2); PG8_STB(PG8_SB(0, 1), b2 + hstepB); PG8_STA(PG8_SA(0, 0), a2, v2, 0);
            PG8_WAIT_V(8); PG8_WAIT_L(0); PG8_BAR; PG8_MMA(1, 0, At, B0); PG8_MMA(1, 1, At, B1); PG8_BAR; PG8_SCHED;
            PG8_LDB(B0, 1, 0); PG8_LDB(B1, 1, 1); PG8_SCHED; PG8_LDA(At, 1, 0); PG8_STA(PG8_SA(0, 1), a2, v2, 1);
            PG8_WAIT_V(8); PG8_WAIT_L(0); PG8_BAR; PG8_MMA(0, 0, At, B0); PG8_MMA(0, 1, At, B1); PG8_BAR; PG8_SCHED;
            PG8_LDA(At, 1, 1); PG8_STB(PG8_SB(1, 0), b3); PG8_STB(PG8_SB(1, 1), b3 + hstepB); PG8_STA(PG8_SA(1, 0), a3, v2, 0);
            PG8_WAIT_V(8); PG8_WAIT_L(0); PG8_BAR; PG8_MMA(1, 0, At, B0); PG8_MMA(1, 1, At, B1); PG8_BAR; PG8_SCHED;
        }
        if (wr == 0) PG8_BAR;
        epi_run(E, acc, cur, wr, wc, fr, fq);
        if (!has_next) break;
#pragma unroll
        for (int a = 0; a < 2; ++a)
#pragma unroll
            for (int b = 0; b < 2; ++b)
#pragma unroll
                for (int m = 0; m < 4; ++m)
#pragma unroll
                    for (int n = 0; n < 2; ++n) acc[a][b][m][n] = (f32x4){0.f, 0.f, 0.f, 0.f};
        cur = nxt; cA = nA; cB = nB; ++ui;
#pragma unroll
        for (int h = 0; h < 2; ++h)
#pragma unroll
            for (int i = 0; i < 2; ++i) vAc[h][i] = vAn[h][i];
        if (wr == 1) PG8_BAR;
    }
    PG8_WAIT_V(0);
    PG8_BAR;
#undef PG8_SA
#undef PG8_SB
#undef PG8_STB
#undef PG8_STA
#undef PG8_LDV
#undef PG8_LDA
#undef PG8_LDB
#undef PG8_MMA
#undef PG8_WAIT_V
#undef PG8_WAIT_L
#undef PG8_BAR
#undef PG8_SCHED
}

__device__ __forceinline__ void glds16_s(const void* sbase, unsigned voff, unsigned lds_dst) { unsigned keep;
    asm volatile("s_mov_b32 %0, m0\n\ts_mov_b32 m0, %3\n\ts_nop 0\n\tglobal_load_lds_dwordx4 %1, %2\n\ts_mov_b32 m0, %0" : "=&s"(keep) : "v"(voff), "s"(sbase), "s"(lds_dst) : "memory"); }
__device__ __forceinline__ void glds4_s(const void* sbase, unsigned voff, unsigned lds_dst) { unsigned keep;
    asm volatile("s_mov_b32 %0, m0\n\ts_mov_b32 m0, %3\n\ts_nop 0\n\tglobal_load_lds_dword %1, %2\n\ts_mov_b32 m0, %0" : "=&s"(keep) : "v"(voff), "s"(sbase), "s"(lds_dst) : "memory"); }
typedef int i32x4 __attribute__((ext_vector_type(4)));
typedef int i32x8 __attribute__((ext_vector_type(8)));
constexpr int SCL_OFF = STAGE_BYTES;
template <class Epi, class Sched, bool GATHER>
__device__ __forceinline__ void gemm_phase_mx(LAS unsigned char* lds, const Dims g, const Sched& S, const Epi& E) {
    const int tid = threadIdx.x, wid = __builtin_amdgcn_readfirstlane(tid >> 6), lane = tid & 63, wr = wid >> 2, wc = wid & 3, fr = lane & 15, fq = lane >> 4;
    const int K = g.K, nt = K / BK;
    unsigned voffB[2];
#pragma unroll
    for (int i = 0; i < 2; ++i) { int R, C; stage_rc(tid * 16 + i * 8192, R, C); const int Rb = (R & ~31) + perm32(R & 31); voffB[i] = (unsigned)(Rb * g.ldb + C) * 2u; }
    const size_t kstep = (size_t)(BK * 2);
    const size_t hstepB = (size_t)HALF * g.ldb * 2;
    const unsigned ldsw = (unsigned)wid * 1024u, ldsb = (unsigned)(unsigned long)lds;
    const int aoff = lds_byte(wr * 64 + fr, fq * 8), boff = lds_byte(wc * 32 + fr, fq * 8);
    const unsigned ldab = (unsigned)g.lda * 2u;
    const int si_ = (wid & 3) * 64 + lane;
    const int srow = ((si_ >> 2) & 1) * 128 + (si_ >> 7) * 64 + (si_ & 3) * 16 + ((si_ >> 3) & 15);
    const int sslot = ((si_ >> 1) & 1) * 128 + (si_ >> 6) * 32 + (si_ & 1) * 16 + ((si_ >> 2) & 15);
    const int sBrow = (sslot & 128) + ((sslot & 127) & ~31) + perm32(sslot & 31);
    const unsigned sldst = (unsigned)(SCL_OFF + (wid >> 2) * 1024 + (wid & 3) * 256);
    unsigned a_rd = ldsb + (unsigned)aoff, b_rd = ldsb + (unsigned)(boff + 4 * HTB), sa_rd = ldsb + (unsigned)(SCL_OFF + (wr * 16 + fr) * 32), sb_rd = ldsb + (unsigned)(SCL_OFF + 1024 + (wc * 16 + fr) * 16);
    int ssh = fq * 8;
    asm volatile("" : "+v"(a_rd), "+v"(b_rd), "+v"(sa_rd), "+v"(sb_rd), "+v"(ssh));
#define PG8_SA(b, h) (((b) * 2 + (h)) * HTB)
#define PG8_SB(b, h) ((4 + (b) * 2 + (h)) * HTB)
#define PG8_STB(bufoff, gbase) do { _Pragma("unroll") for (int _i = 0; _i < 2; ++_i) glds16_s((gbase), voffB[_i], ldsb + (unsigned)((bufoff) + _i * 8192) + ldsw); } while (0)
#define PG8_STA(bufoff, gbase, V, h) do { _Pragma("unroll") for (int _i = 0; _i < 2; ++_i) glds16_s((gbase), (V)[h][_i], ldsb + (unsigned)((bufoff) + _i * 8192) + ldsw); } while (0)
#define PG8_STS(b, sp, so) glds4_s((sp), (so), ldsb + sldst + (unsigned)((b) * 2048))
#define PG8_LDV(u_, V) do { int tl_ = tid; asm volatile("" : "+v"(tl_)); const int* rw_ = GATHER ? S.rows(u_) : nullptr; \
        _Pragma("unroll") for (int i_ = 0; i_ < 2; ++i_) { int R_, C_; stage_rc(tl_ * 16 + i_ * 8192, R_, C_); \
        _Pragma("unroll") for (int h_ = 0; h_ < 2; ++h_) (V)[h_][i_] = (unsigned)(GATHER ? rw_[h_ * HALF + R_] : (h_ * HALF + R_)) * ldab + (unsigned)C_ * 2u; } } while (0)
#define PG8_SBASE(u_) ((wid < 4) ? (const char*)S.sa_base(u_) : (const char*)S.sb_base(u_))
#define PG8_SOFF(u_) ((unsigned)((wid < 4) ? (GATHER ? S.rows(u_)[srow] : srow) : sBrow) * (unsigned)(nt * 4))
#define PG8_LDA(dst, b, h) do { _Pragma("unroll") for (int m = 0; m < 4; ++m) _Pragma("unroll") for (int k = 0; k < 2; ++k) dst[m][k] = *(const LAS i32x4*)(unsigned long)(a_rd + (unsigned)(PG8_SA(b, h) + m * 2048 + k * 1024)); } while (0)
#define PG8_LDB(dst, b, h) do { _Pragma("unroll") for (int n = 0; n < 2; ++n) _Pragma("unroll") for (int k = 0; k < 2; ++k) dst[n][k] = *(const LAS i32x4*)(unsigned long)(b_rd + (unsigned)(((b) * 2 + (h)) * HTB + n * 2048 + k * 1024)); } while (0)
#define PG8_U8(off) ((unsigned)*(const LAS unsigned char*)(unsigned long)(off))
#define PG8_LDSC(b) do { const i32x4 a0_ = *(const LAS i32x4*)(unsigned long)(sa_rd + (unsigned)((b) * 2048)), a1_ = *(const LAS i32x4*)(unsigned long)(sa_rd + (unsigned)((b) * 2048 + 16)), \
        b0_ = *(const LAS i32x4*)(unsigned long)(sb_rd + (unsigned)((b) * 2048)); \
        _Pragma("unroll") for (int q_ = 0; q_ < 4; ++q_) { scA[q_] = a0_[q_]; scA[4 + q_] = a1_[q_]; scB[q_] = b0_[q_]; } } while (0)
#define PG8_SCSH do { _Pragma("unroll") for (int q_ = 0; q_ < 8; ++q_) scA[q_] = (int)((unsigned)scA[q_] >> ssh); _Pragma("unroll") for (int q_ = 0; q_ < 4; ++q_) scB[q_] = (int)((unsigned)scB[q_] >> ssh); } while (0)
#define PG8_CAT(x) (i32x8){x[0][0], x[0][1], x[0][2], x[0][3], x[1][0], x[1][1], x[1][2], x[1][3]}
#define PG8_MM1(ai, bj, m, n, At, Bt) acc[ai][bj][m][n] = __builtin_amdgcn_mfma_scale_f32_16x16x128_f8f6f4(PG8_CAT(Bt[n]), PG8_CAT(At[m]), acc[ai][bj][m][n], 0, 0, 0, scB[(bj) * 2 + (n)], 0, scA[(ai) * 4 + (m)])
#define PG8_MMA(ai, bj, At, Bt) do { __builtin_amdgcn_s_setprio(1); PG8_MM1(ai, bj, 0, 0, At, Bt); PG8_MM1(ai, bj, 0, 1, At, Bt); PG8_MM1(ai, bj, 1, 0, At, Bt); PG8_MM1(ai, bj, 1, 1, At, Bt); \
        PG8_MM1(ai, bj, 2, 0, At, Bt); PG8_MM1(ai, bj, 2, 1, At, Bt); PG8_MM1(ai, bj, 3, 0, At, Bt); PG8_MM1(ai, bj, 3, 1, At, Bt); __builtin_amdgcn_s_setprio(0); } while (0)
#define PG8_WAIT_V(n) asm volatile("s_waitcnt vmcnt(" #n ")" ::: "memory")
#define PG8_WAIT_L(n) asm volatile("s_waitcnt lgkmcnt(" #n ")" ::: "memory")
#define PG8_BAR __builtin_amdgcn_s_barrier()
#define PG8_SCHED __builtin_amdgcn_sched_barrier(0)
    Unit cur, nxt; int ui = 0;
    if (!S.next(0, cur)) return;
    f32x4 acc[2][2][4][2];
#pragma unroll
    for (int a = 0; a < 2; ++a)
#pragma unroll
        for (int b = 0; b < 2; ++b)
#pragma unroll
            for (int m = 0; m < 4; ++m)
#pragma unroll
                for (int n = 0; n < 2; ++n) acc[a][b][m][n] = (f32x4){0.f, 0.f, 0.f, 0.f};
    i32x4 At[4][2], B0[2][2], B1[2][2]; int scA[8], scB[4];
    unsigned vAc[2][2], vAn[2][2];
    const char* cA = S.abase(cur); const char* cB = S.bbase(cur);
    const char* sBc = PG8_SBASE(cur); const char* sBn = sBc; unsigned sOc = PG8_SOFF(cur), sOn = sOc;
    PG8_LDV(cur, vAc);
    PG8_STS(0, sBc, sOc);
    PG8_STB(PG8_SB(0, 0), cB); PG8_STB(PG8_SB(0, 1), cB + hstepB); PG8_STA(PG8_SA(0, 0), cA, vAc, 0); PG8_STA(PG8_SA(0, 1), cA, vAc, 1);
    if (wr == 1) PG8_BAR;
    PG8_WAIT_V(2); PG8_BAR;
    PG8_STS(1, sBc + 4, sOc);
    PG8_STB(PG8_SB(1, 0), cB + kstep); PG8_STA(PG8_SA(1, 0), cA + kstep, vAc, 0); PG8_STB(PG8_SB(1, 1), cB + hstepB + kstep);
    PG8_WAIT_V(6); PG8_BAR;
    for (;;) {
        const bool has_next = S.next(ui + 1, nxt);
        const char* nA = has_next ? S.abase(nxt) : cA; const char* nB = has_next ? S.bbase(nxt) : cB;
        if (has_next) { PG8_LDV(nxt, vAn); sBn = PG8_SBASE(nxt); sOn = PG8_SOFF(nxt); }
        else { sBn = sBc; sOn = sOc;
#pragma unroll
            for (int h = 0; h < 2; ++h)
#pragma unroll
                for (int i = 0; i < 2; ++i) vAn[h][i] = vAc[h][i];
        }
        for (int t = 0; t < nt; t += 2) {
            const bool last = (t == nt - 2);
            const char* a1 = cA + (size_t)(t + 1) * kstep;
            const char* a2 = last ? nA : cA + (size_t)(t + 2) * kstep; const char* b2 = last ? nB : cB + (size_t)(t + 2) * kstep;
            const char* a3 = a2 + kstep; const char* b3 = b2 + kstep;
            const char* s2 = last ? sBn : sBc + (size_t)(t + 2) * 4;
            PG8_LDB(B0, 0, 0); PG8_LDB(B1, 0, 1); PG8_LDSC(0); PG8_SCHED; PG8_LDA(At, 0, 0); PG8_STA(PG8_SA(1, 1), a1, vAc, 1);
            if (last) { sOc = sOn;
#pragma unroll
                for (int h = 0; h < 2; ++h)
#pragma unroll
                    for (int i = 0; i < 2; ++i) vAc[h][i] = vAn[h][i]; }
            PG8_WAIT_V(9); PG8_WAIT_L(0); PG8_BAR; PG8_SCSH; PG8_MMA(0, 0, At, B0); PG8_MMA(0, 1, At, B1); PG8_BAR; PG8_SCHED;
            PG8_LDA(At, 0, 1); PG8_STB(PG8_SB(0, 0), b2); PG8_STB(PG8_SB(0, 1), b2 + hstepB); PG8_STA(PG8_SA(0, 0), a2, vAc, 0); PG8_STS(0, s2, sOc);
            PG8_WAIT_V(9); PG8_WAIT_L(0); PG8_BAR; PG8_MMA(1, 0, At, B0); PG8_MMA(1, 1, At, B1); PG8_BAR; PG8_SCHED;
            PG8_LDB(B0, 1, 0); PG8_LDB(B1, 1, 1); PG8_LDSC(1); PG8_SCHED; PG8_LDA(At, 1, 0); PG8_STA(PG8_SA(0, 1), a2, vAc, 1);
            PG8_WAIT_V(9); PG8_WAIT_L(0); PG8_BAR; PG8_SCSH; PG8_MMA(0, 0, At, B0); PG8_MMA(0, 1, At, B1); PG8_BAR; PG8_SCHED;
            PG8_LDA(At, 1, 1); PG8_STB(PG8_SB(1, 0), b3); PG8_STB(PG8_SB(1, 1), b3 + hstepB); PG8_STA(PG8_SA(1, 0), a3, vAc, 0); PG8_STS(1, s2 + 4, sOc);
            PG8_WAIT_V(9); PG8_WAIT_L(0); PG8_BAR; PG8_MMA(1, 0, At, B0); PG8_MMA(1, 1, At, B1); PG8_BAR; PG8_SCHED;
        }
        if (wr == 0) PG8_BAR;
        epi_run(E, acc, cur, wr, wc, fr, fq);
        if (!has_next) break;
#pragma unroll
        for (int a = 0; a < 2; ++a)
#pragma unroll
            for (int b = 0; b < 2; ++b)
#pragma unroll
                for (int m = 0; m < 4; ++m)
#pragma unroll
                    for (int n = 0; n < 2; ++n) acc[a][b][m][n] = (f32x4){0.f, 0.f, 0.f, 0.f};
        cur = nxt; cA = nA; cB = nB; sBc = sBn; sOc = sOn; ++ui;
#pragma unroll
        for (int h = 0; h < 2; ++h)
#pragma unroll
            for (int i = 0; i < 2; ++i) vAc[h][i] = vAn[h][i];
        if (wr == 1) PG8_BAR;
    }
    PG8_WAIT_V(0);
    PG8_BAR;
#undef PG8_SA
#undef PG8_SB
#undef PG8_STB
#undef PG8_STA
#undef PG8_STS
#undef PG8_LDV
#undef PG8_SBASE
#undef PG8_SOFF
#undef PG8_LDA
#undef PG8_LDB
#undef PG8_LDSC
#undef PG8_SCSH
#undef PG8_U8
#undef PG8_MM1
#undef PG8_CAT
#undef PG8_MMA
#undef PG8_WAIT_V
#undef PG8_WAIT_L
#undef PG8_BAR
#undef PG8_SCHED
}

template <class Epi, class Sched, bool GATHER>
__device__ __forceinline__ void gemm_naive(const Dims g, const Sched& S, const Epi& E) {
    Unit u;
    for (int i = 0; S.next(i, u); ++i) {
        const char* aB = S.abase(u); const char* bB = S.bbase(u);
        for (int item = threadIdx.x; item < 4096; item += NTHREADS) {
            const int r = item >> 4, cg = item & 15;
            const char* arow;
            if constexpr (GATHER) arow = aB + (size_t)S.rows(u)[r] * g.lda * 2; else arow = aB + (size_t)r * g.lda * 2;
            float a[8], b[8];
#pragma unroll
            for (int j = 0; j < 8; ++j) { a[j] = 0.f; b[j] = 0.f; }
            for (int k8 = 0; k8 < g.K / 8; ++k8) {
                float av[8]; ld8bf((const bf16_t*)(arow + k8 * 16), av);
#pragma unroll
                for (int j = 0; j < 8; ++j) {
                    float bv[8]; ld8bf((const bf16_t*)(bB + (size_t)(cg * 8 + j) * g.ldb * 2 + k8 * 16), bv);
                    float s = 0.f;
#pragma unroll
                    for (int q = 0; q < 8; ++q) s += av[q] * bv[q];
                    a[j] += s;
                    ld8bf((const bf16_t*)(bB + (size_t)(128 + cg * 8 + j) * g.ldb * 2 + k8 * 16), bv);
                    s = 0.f;
#pragma unroll
                    for (int q = 0; q < 8; ++q) s += av[q] * bv[q];
                    b[j] += s;
                }
            }
            E.store8(u, r, cg, a, b);
        }
    }
}

template <class Epi, class Sched, bool GATHER>
__device__ __forceinline__ void gemm_run(LAS unsigned char* lds, const Dims g, const Sched& S, const Epi& E) {
#if NAIVE_GEMM
    gemm_naive<Epi, Sched, GATHER>(g, S, E);
#else
    gemm_phase<Epi, Sched, GATHER>(lds, g, S, E);
#endif
}

struct RegOrder {
    const char* A; const char* Bt; int lda, ldb; int nM, nN, nwg, G, c;
    __device__ __forceinline__ void init(const void* A_, const void* Bt_, int lda_, int ldb_, int M, int N, int G_, int c_) { A = (const char*)A_; Bt = (const char*)Bt_; lda = lda_; ldb = ldb_; nM = M / BM; nN = N / BM; nwg = nM * nN; G = G_; c = c_; }
    __device__ __forceinline__ bool next(int i, Unit& u) const {
        const long L = (long)i * G + c; if (L >= nwg) return false;
        int wgid = (int)L; { const int q = nwg / NXCD, r = nwg % NXCD, xcd = wgid % NXCD, off = wgid / NXCD; wgid = (xcd < r ? xcd * (q + 1) : r * (q + 1) + (xcd - r) * q) + off; }
        const int nig = WGM * nN, gid = wgid / nig, fm = gid * WGM, gsz = (nM - fm) < WGM ? (nM - fm) : WGM;
        u.pm = fm + ((wgid % nig) % gsz); u.pn = (wgid % nig) / gsz; u.aux = 0; return true;
    }
    __device__ __forceinline__ const char* abase(const Unit& u) const { return A + (size_t)u.pm * BM * lda * 2; }
    __device__ __forceinline__ const char* bbase(const Unit& u) const { return Bt + (size_t)u.pn * BM * ldb * 2; }
    __device__ __forceinline__ const int* rows(const Unit&) const { return nullptr; }
};
struct RegOrderMx : RegOrder {
    const unsigned* sA; const unsigned* sB; int nt;
    __device__ __forceinline__ const unsigned* sa_base(const Unit& u) const { return sA + (size_t)u.pm * BM * nt; }
    __device__ __forceinline__ const unsigned* sb_base(const Unit& u) const { return sB + (size_t)u.pn * BM * nt; }
};
struct SsmOrder {
    const char* A; const char* Bt; int nPN, ldb, nrowsB, G, c;
    __device__ __forceinline__ bool next(int i, Unit& u) const {
        const int L = i * G + c; if (L >= NGRP * 2 * nPN) return false;
        u.aux = L / (2 * nPN); const int r = L % (2 * nPN); u.pm = r / nPN; u.pn = r % nPN; return true;
    }
    __device__ __forceinline__ const char* abase(const Unit& u) const { return A + ((size_t)u.aux * GROWS + (size_t)u.pm * BM) * UEXT_LD * 2; }
    __device__ __forceinline__ const char* bbase(const Unit& u) const { return Bt + ((size_t)u.aux * nrowsB + (size_t)u.pn * BM) * ldb * 2; }
    __device__ __forceinline__ const int* rows(const Unit&) const { return nullptr; }
};
struct MoeOrder {
    const char* A; const char* Bt; const int* slot_tok; const LAS int* tstart; int nN, ldb, nrowsB, lda, G, c;
    __device__ __forceinline__ bool next(int i, Unit& u) const {
        const int NT = tstart[NEXP]; const int L = i * G + c; if (L >= NT * nN) return false;
        const int tile = L / nN; u.pn = L % nN; u.pm = tile; int e = 0;
#pragma unroll
        for (int k = 1; k < NEXP; ++k) e += (tstart[k] <= tile) ? 1 : 0;
        u.aux = __builtin_amdgcn_readfirstlane(e); return true;
    }
    __device__ __forceinline__ const char* abase(const Unit& u) const { return lists ? A + ((size_t)u.aux * 16384 + (size_t)(u.pm - tstart[u.aux]) * BM) * lda * 2 : (slot_tok ? A : A + (size_t)u.pm * BM * lda * 2); }
    __device__ __forceinline__ const char* bbase(const Unit& u) const { return Bt + ((size_t)u.aux * nrowsB + (size_t)u.pn * BM) * ldb * 2; }
    __device__ __forceinline__ const int* rows(const Unit& u) const { return slot_tok + (size_t)u.pm * BM; }
    const unsigned* sA; const unsigned* sB; int nt; int lists;
    __device__ __forceinline__ const unsigned* sa_base(const Unit& u) const { return lists ? sA + ((size_t)u.aux * 16384 + (size_t)(u.pm - tstart[u.aux]) * BM) * nt : (slot_tok ? sA : sA + (size_t)u.pm * BM * nt); }
    __device__ __forceinline__ const unsigned* sb_base(const Unit& u) const { return sB + ((size_t)u.aux * nrowsB + (size_t)u.pn * BM) * nt; }
};
}

using pg8::Unit;
struct EpiInProj { static constexpr bool PAIR = false; bf16_t *uext, *q, *k, *v, *gs, *ga;
    __device__ __forceinline__ void one(const Unit& u, int m, int c, const float (&x)[8]) const {
        const int reg = u.pn >> 2; const int bb = m >> 13, t = m & 8191;
        if (reg == 0) { const int g = c >> 4, hf = (c >> 3) & 1; st8bf(uext + ((size_t)(g * GROWS + bb * NCHUNK + (t >> 5)) * UEXT_LD + (t & 31) * 16 + hf * 8), x); }
        else if (reg == 1) { float y[8];
#pragma unroll
            for (int j = 0; j < 8; ++j) y[j] = x[j] * QSCALE;
            st8bf(q + (size_t)m * 1024 + (c - 1024), y); }
        else if (reg == 2) st8bf(k + (size_t)m * 1024 + (c - 2048), x);
        else if (reg == 3) st8bf(v + (size_t)m * 1024 + (c - 3072), x);
        else { float y[8];
#pragma unroll
            for (int j = 0; j < 8; ++j) y[j] = sigmoidf_fast(x[j]);
            if (reg < 6) st8bf(gs + (size_t)m * 2048 + (c - 4096), y); else st8bf(ga + (size_t)m * 2048 + (c - 6144), y); }
    }
    __device__ __forceinline__ void store8(const Unit& u, int r, int cg, const float (&a)[8], const float (&b)[8]) const {
        const int m = u.pm * 256 + r, c = u.pn * 256 + cg * 8; one(u, m, c, a); one(u, m, c + 128, b);
    }
};
struct EpiGates { static constexpr bool PAIR = false; bf16_t *gs, *ga;
    __device__ __forceinline__ void one(int m, int c, const float (&x)[8]) const { float y[8];
#pragma unroll
        for (int j = 0; j < 8; ++j) y[j] = sigmoidf_fast(x[j]);
        if (c < 2048) st8bf(gs + (size_t)m * 2048 + c, y); else st8bf(ga + (size_t)m * 2048 + (c - 2048), y); }
    __device__ __forceinline__ void store8(const Unit& u, int r, int cg, const float (&a)[8], const float (&b)[8]) const { const int m = u.pm * 256 + r, c = u.pn * 256 + cg * 8; one(m, c, a); one(m, c + 128, b); }
};
struct EpiS1 { static constexpr bool PAIR = false; float* S;
    __device__ __forceinline__ void store8(const Unit& u, int r, int cg, const float (&a)[8], const float (&b)[8]) const {
        float* p = S + ((size_t)(u.aux * GROWS + u.pm * 256 + r) * 256 + cg * 8);
        *(f32x4*)p = (f32x4){a[0], a[1], a[2], a[3]}; *(f32x4*)(p + 4) = (f32x4){a[4], a[5], a[6], a[7]};
        *(f32x4*)(p + 128) = (f32x4){b[0], b[1], b[2], b[3]}; *(f32x4*)(p + 132) = (f32x4){b[4], b[5], b[6], b[7]};
    }
};
__device__ __forceinline__ float gelu_tanh(float x) { const float z = 0.7978845608028654f * (x + 0.044715f * x * x * x); return x * __builtin_amdgcn_rcpf(1.0f + __builtin_amdgcn_exp2f(-2.0f * LOG2E * z)); }
struct EpiS3 { static constexpr bool PAIR = false; bf16_t* y;
    __device__ __forceinline__ void one(const Unit& u, int row, int col, const float (&x)[8]) const {
        const int bb = row >> 8, c = row & 255, tau = col >> 4, o8 = col & 15; const int m = bb * SEQ + c * CHUNK + tau; float z[8];
#pragma unroll
        for (int j = 0; j < 8; ++j) z[j] = gelu_tanh(x[j]);
        st8bf(y + (size_t)m * SSMW + u.aux * GSZ + o8, z);
    }
    __device__ __forceinline__ void store8(const Unit& u, int r, int cg, const float (&a)[8], const float (&b)[8]) const {
        const int row = u.pm * 256 + r, col = u.pn * 256 + cg * 8; one(u, row, col, a); one(u, row, col + 128, b);
    }
};
struct EpiAO { static constexpr bool PAIR = false; const bf16_t* ga; bf16_t* t2;
    __device__ __forceinline__ void one(int m, int c, const float (&x)[8]) const { float g[8], y[8]; ld8bf(ga + (size_t)m * DM + c, g);
#pragma unroll
        for (int j = 0; j < 8; ++j) y[j] = g[j] * x[j];
        st8bf(t2 + (size_t)m * DM + c, y); }
    __device__ __forceinline__ void store8(const Unit& u, int r, int cg, const float (&a)[8], const float (&b)[8]) const { const int m = u.pm * 256 + r, c = u.pn * 256 + cg * 8; one(m, c, a); one(m, c + 128, b); }
};
struct EpiGLU { static constexpr bool PAIR = false; const bf16_t* gs; const bf16_t* t2; bf16_t* mrg;
    __device__ __forceinline__ void store8(const Unit& u, int r, int cg, const float (&a)[8], const float (&b)[8]) const {
        const int m = u.pm * 256 + r, oc = u.pn * 128 + cg * 8; float g[8], t[8], y[8]; ld8bf(gs + (size_t)m * DM + oc, g); ld8bf(t2 + (size_t)m * DM + oc, t);
#pragma unroll
        for (int j = 0; j < 8; ++j) y[j] = t[j] + g[j] * (a[j] * sigmoidf_fast(b[j]));
        st8bf(mrg + (size_t)m * DM + oc, y);
    }
};
struct EpiGLUQ { static constexpr bool PAIR = true; const bf16_t* gs; const bf16_t* t2; unsigned char* mq; unsigned char* ms;
    struct Ctx { u32x4 g[8], t[8]; };
    __device__ __forceinline__ Ctx prep(const Unit& u, int wr, int cg, int fr) const { Ctx c; const int oc = u.pn * 128 + cg * 8;
#pragma unroll
        for (int i = 0; i < 8; ++i) { const size_t m = (size_t)(u.pm * 256 + (i >> 2) * 128 + wr * 64 + (i & 3) * 16 + fr); c.g[i] = *(const u32x4*)(gs + m * DM + oc); c.t[i] = *(const u32x4*)(t2 + m * DM + oc); }
        return c; }
    __device__ __forceinline__ u32x2 row(const u32x4 gw, const u32x4 tw, const float (&a)[8], const float (&b)[8], unsigned& sb) const {
        float g[8], t[8], y[8]; unpack8(gw, g); unpack8(tw, t); float am = 0.f;
#pragma unroll
        for (int j = 0; j < 8; ++j) { y[j] = t[j] + g[j] * (a[j] * sigmoidf_fast(b[j])); am = fmaxf(am, fabsf(y[j])); }
        am = max_x16_x32(am);
        sb = mx_scale_byte(am); const float scl = __uint_as_float(sb << 23);
        u32x2 o; o.x = fp8x4_scaled(y[0], y[1], y[2], y[3], scl); o.y = fp8x4_scaled(y[4], y[5], y[6], y[7], scl); return o; }
    __device__ __forceinline__ void store_pair(const Unit& u, int r, int cg, const float (&a0)[8], const float (&b0)[8], const float (&a1)[8], const float (&b1)[8], const Ctx& x, int i) const {
        unsigned sb0, sb1; const u32x2 o0 = row(x.g[i], x.t[i], a0, b0, sb0), o1 = row(x.g[i + 1], x.t[i + 1], a1, b1, sb1);
        const int fq = cg & 3, wc = cg >> 2, odd = fq & 1; const size_t m = (size_t)(u.pm * 256 + r + 16 * odd); const int oc = u.pn * 128 + 32 * wc + 8 * (fq & 2);
        *(u32x4*)(mq + m * DM + oc) = pg8::pair_swap(o0, o1);
        ms[m * 64 + (oc >> 5)] = (unsigned char)(odd ? sb1 : sb0);
    }
};
struct EpiOut { static constexpr bool PAIR = false; const float* x; bf16_t* h1;
    __device__ __forceinline__ void one(int m, int c, const float (&v)[8]) const { const float* xp = x + (size_t)m * DM + c;
        const f32x4 x0 = *(const f32x4*)xp, x1 = *(const f32x4*)(xp + 4);
        const float y[8] = {x0[0] + v[0], x0[1] + v[1], x0[2] + v[2], x0[3] + v[3], x1[0] + v[4], x1[1] + v[5], x1[2] + v[6], x1[3] + v[7]};
        st8bf(h1 + (size_t)m * DM + c, y); }
    __device__ __forceinline__ void store8(const Unit& u, int r, int cg, const float (&a)[8], const float (&b)[8]) const { const int m = u.pm * 256 + r, c = u.pn * 256 + cg * 8; one(m, c, a); one(m, c + 128, b); }
};
struct EpiMoe1 { static constexpr bool PAIR = false; const float* b1; bf16_t* act;
    __device__ __forceinline__ void store8(const Unit& u, int r, int cg, const float (&a)[8], const float (&b)[8]) const {
        const int slot = u.pm * 256 + r, oc = u.pn * 128 + cg * 8; const float* bp = b1 + (size_t)u.aux * (2 * DFF) + 2 * oc; float bias[16];
#pragma unroll
        for (int j = 0; j < 4; ++j) { const f32x4 t = *(const f32x4*)(bp + 4 * j); bias[4 * j] = t[0]; bias[4 * j + 1] = t[1]; bias[4 * j + 2] = t[2]; bias[4 * j + 3] = t[3]; }
        float y[8];
#pragma unroll
        for (int j = 0; j < 8; ++j) { const float xg = fminf(a[j] + bias[2 * j], 7.0f); const float xl = fminf(fmaxf(b[j] + bias[2 * j + 1], -7.0f), 7.0f);
            y[j] = xg * sigmoidf_fast(1.702f * xg) * (xl + 1.0f); }
        st8bf(act + (size_t)slot * DFF + oc, y);
    }
};
struct EpiMoe1Q { static constexpr bool PAIR = true; const float* b1; unsigned char* actq; unsigned char* acts;
    struct Ctx { f32x4 t[4]; };
    __device__ __forceinline__ Ctx prep(const Unit& u, int, int cg, int) const { Ctx c; const float* bp = b1 + (size_t)u.aux * (2 * DFF) + 2 * (u.pn * 128 + cg * 8);
#pragma unroll
        for (int j = 0; j < 4; ++j) c.t[j] = *(const f32x4*)(bp + 4 * j);
        return c; }
    __device__ __forceinline__ u32x2 row(const float (&a)[8], const float (&b)[8], const float (&bias)[16], unsigned& sb) const {
        float y[8]; float am = 0.f;
#pragma unroll
        for (int j = 0; j < 8; ++j) { const float xg = fminf(a[j] + bias[2 * j], 7.0f); const float xl = fminf(fmaxf(b[j] + bias[2 * j + 1], -7.0f), 7.0f);
            y[j] = xg * sigmoidf_fast(1.702f * xg) * (xl + 1.0f); am = fmaxf(am, fabsf(y[j])); }
        am = max_x16_x32(am);
        sb = mx_scale_byte(am); const float scl = __uint_as_float(sb << 23);
        u32x2 o; o.x = fp8x4_scaled(y[0], y[1], y[2], y[3], scl); o.y = fp8x4_scaled(y[4], y[5], y[6], y[7], scl); return o; }
    __device__ __forceinline__ void store_pair(const Unit& u, int r, int cg, const float (&a0)[8], const float (&b0)[8], const float (&a1)[8], const float (&b1)[8], const Ctx& c, int) const {
        float bias[16];
#pragma unroll
        for (int j = 0; j < 4; ++j) { bias[4 * j] = c.t[j][0]; bias[4 * j + 1] = c.t[j][1]; bias[4 * j + 2] = c.t[j][2]; bias[4 * j + 3] = c.t[j][3]; }
        unsigned sb0, sb1; const u32x2 o0 = row(a0, b0, bias, sb0), o1 = row(a1, b1, bias, sb1);
        const int fq = cg & 3, wc = cg >> 2, odd = fq & 1; const int slot = u.pm * 256 + r + 16 * odd;
        *(u32x4*)(actq + (size_t)slot * DFF + u.pn * 128 + 32 * wc + 8 * (fq & 2)) = pg8::pair_swap(o0, o1);
        acts[((size_t)slot * 16 + u.pn) * 4 + wc] = (unsigned char)(odd ? sb1 : sb0);
    }
};
struct EpiMoe2Q { static constexpr bool PAIR = true; const float* b2; const float* sgate; unsigned char* ysq; unsigned char* yss;
    struct Ctx { f32x4 b[4]; float g[8]; };
    __device__ __forceinline__ Ctx prep(const Unit& u, int wr, int cg, int fr) const { Ctx c; const float* bp = b2 + (size_t)u.aux * DM + u.pn * 256 + cg * 8;
        c.b[0] = *(const f32x4*)bp; c.b[1] = *(const f32x4*)(bp + 4); c.b[2] = *(const f32x4*)(bp + 128); c.b[3] = *(const f32x4*)(bp + 132);
#pragma unroll
        for (int i = 0; i < 8; ++i) c.g[i] = sgate[u.pm * 256 + (i >> 2) * 128 + wr * 64 + (i & 3) * 16 + fr];
        return c; }
    __device__ __forceinline__ u32x2 row(float gt, const f32x4 b0, const f32x4 b1, const float (&v)[8], unsigned& sb) const {
        float y[8] = {(v[0] + b0[0]) * gt, (v[1] + b0[1]) * gt, (v[2] + b0[2]) * gt, (v[3] + b0[3]) * gt, (v[4] + b1[0]) * gt, (v[5] + b1[1]) * gt, (v[6] + b1[2]) * gt, (v[7] + b1[3]) * gt};
        float am = fmaxf(fmaxf(fmaxf(fabsf(y[0]), fabsf(y[1])), fmaxf(fabsf(y[2]), fabsf(y[3]))), fmaxf(fmaxf(fabsf(y[4]), fabsf(y[5])), fmaxf(fabsf(y[6]), fabsf(y[7]))));
        am = max_x16_x32(am);
        sb = mx_scale_byte(am); const float scl = __uint_as_float(sb << 23);
        u32x2 o; o.x = fp8x4_scaled(y[0], y[1], y[2], y[3], scl); o.y = fp8x4_scaled(y[4], y[5], y[6], y[7], scl); return o; }
    __device__ __forceinline__ void store_pair(const Unit& u, int r, int cg, const float (&a0)[8], const float (&b0)[8], const float (&a1)[8], const float (&b1)[8], const Ctx& x, int i) const {
        const int fq = cg & 3, wc = cg >> 2, odd = fq & 1; const int slot = u.pm * 256 + r + 16 * odd, c = u.pn * 256 + 32 * wc + 8 * (fq & 2); const float g0 = x.g[i], g1 = x.g[i + 1];
        unsigned sa0, sa1, sb0, sb1;
        const u32x2 oa0 = row(g0, x.b[0], x.b[1], a0, sa0), oa1 = row(g1, x.b[0], x.b[1], a1, sa1);
        *(u32x4*)(ysq + (size_t)slot * DM + c) = pg8::pair_swap(oa0, oa1);
        const int ba = c >> 5, bb_ = ba + 4;
        yss[(size_t)slot * 64 + ((ba & 7) << 3) + (ba >> 3)] = (unsigned char)(odd ? sa1 : sa0);
        const u32x2 ob0 = row(g0, x.b[2], x.b[3], b0, sb0), ob1 = row(g1, x.b[2], x.b[3], b1, sb1);
        *(u32x4*)(ysq + (size_t)slot * DM + c + 128) = pg8::pair_swap(ob0, ob1);
        yss[(size_t)slot * 64 + ((bb_ & 7) << 3) + (bb_ >> 3)] = (unsigned char)(odd ? sb1 : sb0);
    }
};
struct EpiMoe2 { static constexpr bool PAIR = false; const float* b2; const float* sgate; bf16_t* ys;
    __device__ __forceinline__ void one(int e, int slot, float gt, int c, const float (&v)[8]) const { const float* bp = b2 + (size_t)e * DM + c; const f32x4 b0 = *(const f32x4*)bp, b1 = *(const f32x4*)(bp + 4);
        float y[8] = {(v[0] + b0[0]) * gt, (v[1] + b0[1]) * gt, (v[2] + b0[2]) * gt, (v[3] + b0[3]) * gt, (v[4] + b1[0]) * gt, (v[5] + b1[1]) * gt, (v[6] + b1[2]) * gt, (v[7] + b1[3]) * gt};
        st8bf(ys + (size_t)slot * DM + c, y); }
    __device__ __forceinline__ void store8(const Unit& u, int r, int cg, const float (&a)[8], const float (&b)[8]) const {
        const int slot = u.pm * 256 + r, c = u.pn * 256 + cg * 8; const float gt = sgate[slot]; one(u.aux, slot, gt, c, a); one(u.aux, slot, gt, c + 128, b);
    }
};

namespace att {
constexpr int NW = 8, QBLK = 32, KVBLK = 64, LD = 1024;
constexpr int SHM_K = KVBLK * DH * 2, SHM_V = KVBLK * DV * 2;
constexpr int OFF_V = 0, OFF_K = 2 * SHM_V, OFF_WS = OFF_K + 2 * SHM_K, ATT_LDS = OFF_WS + NW * 64 * 4;
constexpr float THR = 8.0f;
constexpr int NT = SEQ / KVBLK + 1;
#define KSWZ64(row, chunk) ((row) * 128 + ((((chunk) ^ (((row) >> 1) & 7))) << 4))
#define SBAR() __builtin_amdgcn_sched_barrier(0)
__device__ __forceinline__ int crow(int r, int hi) { return (r & 3) + 8 * (r >> 2) + 4 * hi; }
__device__ __forceinline__ unsigned cvtpk(float lo, float hi) { unsigned r; asm volatile("v_cvt_pk_bf16_f32 %0, %1, %2" : "=v"(r) : "v"(lo), "v"(hi)); return r; }

template <int MODE>
__device__ __forceinline__ void partialSM(f32x16& p0, f32x16& p1, float& m_reg, float& mn, float& alpha, float dqh, float nslope, float c0, float c1) {
    if (MODE == 0) {
#pragma unroll
        for (int r = 0; r < 16; ++r) { if ((r >> 2) >= 2) p0[r] = -1e30f; p1[r] = -1e30f; }
    } else if (MODE == 1) {
#pragma unroll
        for (int r = 0; r < 16; ++r) { const float kk = (float)((r & 3) + 8 * (r >> 2)); p0[r] = fmaf(nslope, fabsf(dqh - kk), p0[r]); p1[r] = fmaf(nslope, fabsf(dqh - (kk + 32.f)), p1[r]); }
    }
    float pm0 = p0[0], pm1 = p1[0];
#pragma unroll
    for (int r = 1; r < 16; ++r) { pm0 = fmaxf(pm0, p0[r]); pm1 = fmaxf(pm1, p1[r]); }
    float pmax = (MODE == 2) ? fmaxf(pm0 + c0, pm1 + c1) : fmaxf(pm0, pm1);
    { auto rr = __builtin_amdgcn_permlane32_swap(__float_as_uint(pmax), __float_as_uint(pmax), false, false); pmax = fmaxf(__uint_as_float(rr[0]), __uint_as_float(rr[1])); }
    if (__builtin_expect(__all(pmax - m_reg <= THR), 1)) { mn = m_reg; alpha = 1.f; }
    else { mn = fmaxf(m_reg, pmax); alpha = __builtin_amdgcn_exp2f(m_reg - mn); m_reg = mn; }
    const float d0 = (MODE == 2) ? c0 - mn : -mn, d1 = (MODE == 2) ? c1 - mn : -mn;
#pragma unroll
    for (int r = 0; r < 16; ++r) { p0[r] += d0; p1[r] += d1; }
#pragma unroll
    for (int r = 0; r < 16; ++r) p0[r] = __builtin_amdgcn_exp2f(p0[r]);
}
__device__ __forceinline__ void finishSM(f32x16& p0, f32x16& p1, float alpha, float& l_reg, bf16x8& pa0, bf16x8& pa1, bf16x8& pa2, bf16x8& pa3) {
#pragma unroll
    for (int r = 0; r < 16; ++r) p1[r] = __builtin_amdgcn_exp2f(p1[r]);
    float ps = 0;
#pragma unroll
    for (int r = 0; r < 16; ++r) ps += p0[r];
#pragma unroll
    for (int r = 0; r < 16; ++r) ps += p1[r];
    { auto rr = __builtin_amdgcn_permlane32_swap(__float_as_uint(ps), __float_as_uint(ps), false, false); ps = __uint_as_float(rr[0]) + __uint_as_float(rr[1]); }
    l_reg = l_reg * alpha + ps;
#define PK4(P, BASE, OUT) do { unsigned a0 = cvtpk(P[BASE + 0], P[BASE + 1]), a1 = cvtpk(P[BASE + 2], P[BASE + 3]);   \
    unsigned b0 = cvtpk(P[BASE + 4], P[BASE + 5]), b1 = cvtpk(P[BASE + 6], P[BASE + 7]);                              \
    auto r0 = __builtin_amdgcn_permlane32_swap(a0, b0, false, false); auto r1 = __builtin_amdgcn_permlane32_swap(a1, b1, false, false); \
    u32x4 w = {r0[0], r1[0], r0[1], r1[1]}; OUT = *reinterpret_cast<bf16x8*>(&w); } while (0)
    PK4(p0, 0, pa0); PK4(p0, 8, pa1); PK4(p1, 0, pa2); PK4(p1, 8, pa3);
#undef PK4
}
__device__ __forceinline__ void qkt(f32x16& p0, f32x16& p1, const char* Ks, const bf16x8* qr, int r32, int hi, float sg) {
    f32x16 iv; const float sgh = sg * (float)(4 * hi);
#pragma unroll
    for (int r = 0; r < 16; ++r) iv[r] = fmaf(sg, (float)((r & 3) + 8 * (r >> 2)), sgh);
#pragma unroll
    for (int d0 = 0; d0 < 4; ++d0) { const int ch = d0 * 2 + hi;
        const bf16x8 b0 = *reinterpret_cast<const bf16x8*>(Ks + KSWZ64(r32, ch));
        const bf16x8 b1 = *reinterpret_cast<const bf16x8*>(Ks + KSWZ64(32 + r32, ch));
        p0 = __builtin_amdgcn_mfma_f32_32x32x16_bf16(b0, qr[d0], d0 == 0 ? iv : p0, 0, 0, 0);
        p1 = __builtin_amdgcn_mfma_f32_32x32x16_bf16(b1, qr[d0], d0 == 0 ? iv : p1, 0, 0, 0); }
}
__device__ __forceinline__ int v_st(int k, int c) { const int kk = (k & ~0xC) | ((k & 4) << 1) | ((k & 8) >> 1); return ((kk >> 3) * 4 + (c >> 5)) * 512 + ((kk & 7) * 32 + (c & 31)) * 2; }
__device__ __forceinline__ int v_rd_base(int lane) { return ((lane & 3) << 3) | (((lane >> 2) & 3) << 6) | (((lane >> 4) & 1) << 5) | (((lane >> 5) & 1) << 8); }
constexpr int v_rd_off(int d0, int ks, int half) { return d0 * 512 + ks * 4096 + half * 2048; }
template <int OFF> __device__ __forceinline__ s16x4 tr_read(int vb) { s16x4 r; asm volatile("ds_read_b64_tr_b16 %0, %1 offset:%2" : "=&v"(r) : "v"(vb), "i"(OFF) : "memory"); return r; }
template <int D0> __device__ __forceinline__ void pv_one(f32x16& od, int vb, bf16x8 pa0, bf16x8 pa1, bf16x8 pa2, bf16x8 pa3) {
    const s16x4 l0 = tr_read<v_rd_off(D0, 0, 0)>(vb), h0 = tr_read<v_rd_off(D0, 0, 1)>(vb), l1 = tr_read<v_rd_off(D0, 1, 0)>(vb), h1 = tr_read<v_rd_off(D0, 1, 1)>(vb);
    const s16x4 l2 = tr_read<v_rd_off(D0, 2, 0)>(vb), h2 = tr_read<v_rd_off(D0, 2, 1)>(vb), l3 = tr_read<v_rd_off(D0, 3, 0)>(vb), h3 = tr_read<v_rd_off(D0, 3, 1)>(vb);
    asm volatile("s_waitcnt lgkmcnt(0)" ::: "memory"); SBAR();
#define PK(L, H) (bf16x8){L[0], L[1], L[2], L[3], H[0], H[1], H[2], H[3]}
    od = __builtin_amdgcn_mfma_f32_32x32x16_bf16(pa0, PK(l0, h0), od, 0, 0, 0);
    od = __builtin_amdgcn_mfma_f32_32x32x16_bf16(pa1, PK(l1, h1), od, 0, 0, 0);
    od = __builtin_amdgcn_mfma_f32_32x32x16_bf16(pa2, PK(l2, h2), od, 0, 0, 0);
    od = __builtin_amdgcn_mfma_f32_32x32x16_bf16(pa3, PK(l3, h3), od, 0, 0, 0);
#undef PK
}
__device__ __forceinline__ void pv_d0(f32x16* o, int vb, bf16x8 pa0, bf16x8 pa1, bf16x8 pa2, bf16x8 pa3) {
    pv_one<0>(o[0], vb, pa0, pa1, pa2, pa3); pv_one<1>(o[1], vb, pa0, pa1, pa2, pa3); pv_one<2>(o[2], vb, pa0, pa1, pa2, pa3); pv_one<3>(o[3], vb, pa0, pa1, pa2, pa3);
}
__device__ __forceinline__ void attn_unit(const bf16_t* __restrict__ Qb, const bf16_t* __restrict__ Kh, const bf16_t* __restrict__ Vh, const bf16_t* __restrict__ Km, const bf16_t* __restrict__ Vm,
                                          bf16_t* __restrict__ Ob, int q0, float nslope, char* lds, int t_lo, int n) {
#define TL(s_) (((s_) == 0) ? 0 : t_lo + (s_) - 1)
    const int tid = threadIdx.x, wid = tid >> 6, lane = tid & 63, r32 = lane & 31, hi = lane >> 5;
    char* V_lds = lds + OFF_V; char* K_lds = lds + OFF_K;
    float* ws = (float*)(lds + OFF_WS) + wid * 64; float* li_l = ws; float* al_l = ws + 32;
    float m_reg = -1e30f, l_reg = 0; f32x16 o[4] = {}; bf16x8 qr[4];
    const bf16_t* Qw = Qb + (long)(wid * QBLK + r32) * LD + hi * 8;
#pragma unroll
    for (int d0 = 0; d0 < 4; ++d0) qr[d0] = *reinterpret_cast<const bf16x8*>(Qw + d0 * 16);
    const int sr = tid >> 4, sc = (tid & 15) * 8, vst0 = v_st(sr, sc), vst1 = v_st(32 + sr, sc);
    const int skr = tid >> 3, skc = tid & 7, kst = KSWZ64(skr, skc);
    const int vb0 = (int)(uintptr_t)V_lds + v_rd_base(lane);
    struct { bf16x8 vs0, vs1, ks; } sr_[2];
    const float qpos = (float)(q0 + wid * QBLK + r32) - 4.0f * (float)hi;
#define SLOAD(i, t) do { const int t_ = (t); const bf16_t* kp_ = (t_ == 0) ? Km : Kh + (long)(t_ - 1) * KVBLK * LD; const bf16_t* vp_ = (t_ == 0) ? Vm : Vh + (long)(t_ - 1) * KVBLK * LD; \
    sr_[i].vs0 = *reinterpret_cast<const bf16x8*>(vp_ + (long)sr * LD + sc); sr_[i].vs1 = *reinterpret_cast<const bf16x8*>(vp_ + (long)(32 + sr) * LD + sc); \
    sr_[i].ks = *reinterpret_cast<const bf16x8*>(kp_ + (long)skr * LD + skc * 8); } while (0)
#define SWRITE(b, i) do { *(bf16x8*)(V_lds + (b) * SHM_V + vst0) = sr_[i].vs0; *(bf16x8*)(V_lds + (b) * SHM_V + vst1) = sr_[i].vs1; *(bf16x8*)(K_lds + (b) * SHM_K + kst) = sr_[i].ks; } while (0)
#define RESC(a) do { if (__any((a) < 1.f)) { if (hi == 0) al_l[r32] = (a); asm volatile("s_waitcnt lgkmcnt(0)" ::: "memory"); \
    _Pragma("unroll") for (int d = 0; d < 4; ++d) _Pragma("unroll") for (int r = 0; r < 16; ++r) o[d][r] *= al_l[crow(r, hi)]; } } while (0)
#define DQ(t) (qpos - (float)(((t) - 1) * KVBLK))
    const int qlo = q0 + wid * QBLK; const float sl2 = -nslope, qposf = (float)(qlo + r32);
#define TSIDE(t) ((((t) - 1) * KVBLK + KVBLK - 1 < qlo) ? 1 : ((((t) - 1) * KVBLK > qlo + QBLK - 1) ? -1 : 0))
#define PSM(P0, P1, MN, AL, t) do { const int sd_ = TSIDE(t); \
        if (sd_ == 0) partialSM<1>(P0, P1, m_reg, MN, AL, DQ(t), nslope, 0.f, 0.f); \
        else { const float sg_ = sd_ > 0 ? sl2 : -sl2; const float c0_ = sg_ * ((float)(((t) - 1) * KVBLK) - qposf); partialSM<2>(P0, P1, m_reg, MN, AL, 0.f, nslope, c0_, c0_ + 32.f * sg_); } } while (0)
#define QKT(P0, P1, KS, t) do { const int sd_ = TSIDE(t); qkt(P0, P1, KS, qr, r32, hi, sd_ > 0 ? sl2 : (sd_ < 0 ? -sl2 : 0.f)); } while (0)
    f32x16 pA0, pA1, pB0, pB1; float mnA, mnB, alA, alB; bf16x8 pa0, pa1, pa2, pa3;
    constexpr int SE = 0, SO = 1;
    SLOAD(SE, 0); asm volatile("s_waitcnt vmcnt(0)" ::: "memory"); SWRITE(0, SE); __syncthreads();
    qkt(pA0, pA1, K_lds, qr, r32, hi, 0.f); partialSM<0>(pA0, pA1, m_reg, mnA, alA, 0.f, nslope, 0.f, 0.f);
    SLOAD(SO, TL(1)); SLOAD(SE, TL(2));
    asm volatile("s_waitcnt vmcnt(3)" ::: "memory"); SWRITE(1, SO); __syncthreads();
    for (int j = 1; j + 1 < n; j += 2) {
        const int tj = TL(j), tj1 = tj + 1;
        SBAR(); QKT(pB0, pB1, K_lds + SHM_K, tj);
        finishSM(pA0, pA1, alA, l_reg, pa0, pa1, pa2, pa3); SBAR();
        if (j + 2 < n) SLOAD(SO, tj + 2);
        SBAR();
        pv_d0(o, vb0, pa0, pa1, pa2, pa3); PSM(pB0, pB1, mnB, alB, tj);
        __syncthreads(); if (j + 2 < n) asm volatile("s_waitcnt vmcnt(3)" ::: "memory"); SWRITE(0, SE);
        RESC(alB); __syncthreads();
        SBAR(); QKT(pA0, pA1, K_lds, tj1);
        finishSM(pB0, pB1, alB, l_reg, pa0, pa1, pa2, pa3); SBAR();
        if (j + 3 < n) SLOAD(SE, tj + 3);
        SBAR();
        pv_d0(o, vb0 + SHM_V, pa0, pa1, pa2, pa3); PSM(pA0, pA1, mnA, alA, tj1);
        __syncthreads();
        if (j + 2 < n) { if (j + 3 < n) asm volatile("s_waitcnt vmcnt(3)" ::: "memory"); SWRITE(1, SO); }
        RESC(alA); __syncthreads();
    }
    finishSM(pA0, pA1, alA, l_reg, pa0, pa1, pa2, pa3); SBAR();
    pv_d0(o, vb0, pa0, pa1, pa2, pa3);
    if (hi == 0) li_l[r32] = l_reg; asm volatile("s_waitcnt lgkmcnt(0)" ::: "memory");
    float rli[16];
#pragma unroll
    for (int r = 0; r < 16; ++r) rli[r] = __builtin_amdgcn_rcpf(li_l[crow(r, hi)]);
    bf16_t* Ow = Ob + (long)(wid * QBLK) * 2048;
#pragma unroll
    for (int r = 0; r < 16; ++r) { const int orow = crow(r, hi);
#pragma unroll
        for (int d0 = 0; d0 < 4; ++d0) Ow[(long)orow * 2048 + d0 * 32 + r32] = (bf16_t)(pk_bf16(o[d0][r] * rli[r], 0.f) & 0xffffu); }
    __syncthreads();
#undef SLOAD
#undef SWRITE
#undef RESC
#undef DQ
#undef TSIDE
#undef PSM
#undef QKT
#undef TL
}
static_assert((NT & 1) == 1, "the tail assumes an odd tile count");
}

#define XB_TMO      128
#define XB_XCNT(j)  (256  + 64 * (j))
#define XB_XSUB(j)  (1280 + 64 * (j))
#define XB_XGEN(j)  (2304 + 64 * (j))
#define XB_TOP      3328
#define XB_TOPGEN   3392
#define XCD_BAR_WORDS 3456
#define XB_SPIN_CAP (1u << 18)
__device__ __forceinline__ unsigned xb_ld(unsigned* p)              { return __hip_atomic_load(p, __ATOMIC_RELAXED, __HIP_MEMORY_SCOPE_AGENT); }
__device__ __forceinline__ unsigned xb_add(unsigned* p, unsigned v) { return __hip_atomic_fetch_add(p, v, __ATOMIC_RELAXED, __HIP_MEMORY_SCOPE_AGENT); }
__device__ __forceinline__ unsigned xb_xcc_id() { return (unsigned)__builtin_amdgcn_s_getreg((3 << 11) | 20) & 0xFu; }
#define XB_SPIN(cond, bar) do { unsigned _sp = 0; while (cond) { __builtin_amdgcn_s_sleep(1); \
    if ((++_sp & 255u) == 0u) { if (xb_ld(&(bar)[XB_TMO])) break; if (_sp > XB_SPIN_CAP) { atomicAdd(&(bar)[XB_TMO], 1u); break; } } } } while (0)
struct XcdBarrier { unsigned* bar; unsigned x; volatile LAS unsigned* st; };
__device__ __forceinline__ XcdBarrier xcd_barrier_post(unsigned* bar, volatile LAS unsigned* st) {
    XcdBarrier b; b.bar = bar; b.x = xb_xcc_id(); b.st = st;
    if (threadIdx.x == 0) (void)xb_add(&bar[XB_XCNT(b.x)], 1u);
    return b;
}
__device__ __forceinline__ void xcd_barrier_complete(unsigned* bar, unsigned x, unsigned& nloc, unsigned& nx) {
    const unsigned G = gridDim.x * gridDim.y * gridDim.z;
    unsigned sum, cnt, mine, sp = 0u;
    for (;;) {
        sum = 0u; cnt = 0u; mine = 0u;
#pragma unroll
        for (unsigned j = 0; j < 16; ++j) { const unsigned c = xb_ld(&bar[XB_XCNT(j)]); sum += c; cnt += (c > 0u) ? 1u : 0u; mine = (j == x) ? c : mine; }
        if (sum == G) break;
        __builtin_amdgcn_s_sleep(1);
        if ((++sp & 255u) == 0u) { if (xb_ld(&bar[XB_TMO])) break; if (sp > XB_SPIN_CAP) { atomicAdd(&bar[XB_TMO], 1u); break; } }
    }
    nloc = mine > 0u ? mine : 1u; nx = cnt > 0u ? cnt : 1u;
}
__device__ __forceinline__ void xcd_barrier(const XcdBarrier& b) {
    asm volatile("s_waitcnt vmcnt(0)" ::: "memory");
    __syncthreads();
    if (threadIdx.x == 0) {
        unsigned* bar = b.bar;
        __builtin_amdgcn_s_waitcnt(0);
        unsigned nloc = b.st[0], nx = b.st[1];
        if (nloc == 0u) { xcd_barrier_complete(bar, b.x, nloc, nx); b.st[0] = nloc; b.st[1] = nx; }
        const unsigned old = xb_add(&bar[XB_XSUB(b.x)], 1u);
        const unsigned gen = old / nloc;
        if (old + 1u == (gen + 1u) * nloc) {
            __builtin_amdgcn_fence(__ATOMIC_RELEASE, "agent");
            asm volatile("s_waitcnt vmcnt(0)" ::: "memory");
            const unsigned og = xb_add(&bar[XB_TOP], 1u);
            const unsigned tg = og / nx;
            if (og + 1u == (tg + 1u) * nx) xb_add(&bar[XB_TOPGEN], 1u);
            else XB_SPIN(xb_ld(&bar[XB_TOPGEN]) == tg, bar);
            __builtin_amdgcn_fence(__ATOMIC_ACQUIRE, "agent");
            xb_add(&bar[XB_XGEN(b.x)], 1u);
            asm volatile("s_waitcnt vmcnt(0)" ::: "memory");
        } else {
            XB_SPIN(xb_ld(&bar[XB_XGEN(b.x)]) == gen, bar);
            __builtin_amdgcn_fence(__ATOMIC_ACQUIRE, "agent");
            asm volatile("s_waitcnt vmcnt(0)" ::: "memory");
        }
    }
    __syncthreads();
}

struct Args { const float* in[35]; float* out; unsigned char* ws; int ph_lo, ph_hi; };
enum { I_X = 0, I_META, I_GMIX, I_WIN, I_LRF, I_LIF, I_DTF, I_BRF, I_BIF, I_CRF, I_CIF, I_LRB, I_LIB, I_DTB, I_BRB, I_BIB, I_CRB, I_CIB, I_SSMD, I_WGLU,
       I_LQ1, I_LK1, I_LQ2, I_LK2, I_SUBG, I_WAO, I_WOUT, I_GMOE, I_WR, I_BR, I_WE1, I_BE1, I_WE2, I_BE2, I_GFIN };
constexpr int NPHASE = 15;

template <class RM>
__device__ __forceinline__ void transpose_item(const float* W, int K, int N, bf16_t* WT, const RM rm, LAS float* scr, int item, int lane, int ldw = 0) {
    if (ldw == 0) ldw = N;
    const int nblk = N / 64, kb = item / nblk, nb = item % nblk, k0 = 64 * kb, n0 = 64 * nb;
    const int lr = lane >> 4, lc = (lane & 15) * 4;
    f32x4 v[16];
#pragma unroll
    for (int i = 0; i < 16; ++i) v[i] = *(const f32x4*)(W + (size_t)(k0 + 4 * i + lr) * ldw + n0 + lc);
#pragma unroll
    for (int i = 0; i < 16; ++i) { LAS float* p = scr + (4 * i + lr) * 65 + lc; p[0] = v[i][0]; p[1] = v[i][1]; p[2] = v[i][2]; p[3] = v[i][3]; }
    LDS_WAIT(); asm volatile("" ::: "memory");
    const int c = lane & 7;
#pragma unroll
    for (int q = 0; q < 8; ++q) { const int n = q * 8 + (lane >> 3); const LAS float* sp = scr + (8 * c) * 65 + n;
        u32x4 o; o.x = pk_bf16(sp[0 * 65], sp[1 * 65]); o.y = pk_bf16(sp[2 * 65], sp[3 * 65]); o.z = pk_bf16(sp[4 * 65], sp[5 * 65]); o.w = pk_bf16(sp[6 * 65], sp[7 * 65]);
        *(u32x4*)(WT + (size_t)rm(n0 + n) * K + k0 + 8 * c) = o; }
    LDS_WAIT(); asm volatile("" ::: "memory");
}
template <class RM>
__device__ __forceinline__ void transpose_item_q(const float* W, int K, int N, unsigned char* WQ, unsigned char* WSC, const RM rm, LAS float* scr, int item, int lane, int ldw = 0) {
    if (ldw == 0) ldw = N;
    const int nblk = N / 32, kb = item / nblk, nb = item % nblk, k0 = 128 * kb, n0 = 32 * nb;
    const int lr = lane >> 3, lc = (lane & 7) * 4;
    f32x4 v[16];
#pragma unroll
    for (int i = 0; i < 16; ++i) v[i] = *(const f32x4*)(W + (size_t)(k0 + 8 * i + lr) * ldw + n0 + lc);
#pragma unroll
    for (int i = 0; i < 16; ++i) { LAS float* p = scr + (8 * i + lr) * 33 + lc; p[0] = v[i][0]; p[1] = v[i][1]; p[2] = v[i][2]; p[3] = v[i][3]; }
    LDS_WAIT(); asm volatile("" ::: "memory");
    const int n = lane & 31, c2 = lane >> 5; const size_t row = (size_t)rm(n0 + n);
    unsigned char* dst = WQ + row * K + k0 + 64 * c2; unsigned sw = 0;
#pragma unroll
    for (int blk = 0; blk < 2; ++blk) { const LAS float* sp = scr + (64 * c2 + 32 * blk) * 33 + n; float x[32]; float am = 0.f;
#pragma unroll
        for (int j = 0; j < 32; ++j) { x[j] = sp[j * 33]; am = fmaxf(am, fabsf(x[j])); }
        const unsigned sb = mx_scale_byte(am); const float inv = mx_inv_scale(sb); sw |= sb << (8 * blk);
#pragma unroll
        for (int h = 0; h < 2; ++h) { u32x4 o;
            o.x = fp8x4(x[16 * h + 0] * inv, x[16 * h + 1] * inv, x[16 * h + 2] * inv, x[16 * h + 3] * inv); o.y = fp8x4(x[16 * h + 4] * inv, x[16 * h + 5] * inv, x[16 * h + 6] * inv, x[16 * h + 7] * inv);
            o.z = fp8x4(x[16 * h + 8] * inv, x[16 * h + 9] * inv, x[16 * h + 10] * inv, x[16 * h + 11] * inv); o.w = fp8x4(x[16 * h + 12] * inv, x[16 * h + 13] * inv, x[16 * h + 14] * inv, x[16 * h + 15] * inv);
            *(u32x4*)(dst + 32 * blk + 16 * h) = o; } }
    const unsigned other = (unsigned)__shfl_xor((int)sw, 32);
    if (c2 == 0) *(unsigned*)(WSC + (row * (K / 128) + kb) * 4) = sw | (other << 16);
    LDS_WAIT(); asm volatile("" ::: "memory");
}
struct RmId { __device__ __forceinline__ int operator()(int n) const { return n; } };
struct RmGlu { __device__ __forceinline__ int operator()(int n) const { const int j = n & 2047, hb = n >> 11; return 256 * (j >> 7) + 128 * hb + (j & 127); } };
struct RmE1 { __device__ __forceinline__ int operator()(int n) const { const int j = n >> 1, lin = n & 1; return 256 * (j >> 7) + 128 * lin + (j & 127); } };

__device__ __forceinline__ void rms_row_bf16(const float* xrow, const float* gain, bf16_t* orow, int lane, unsigned char* qrow = nullptr, unsigned char* qscl = nullptr) {
    f32x4 v[8]; float s = 0.f;
#pragma unroll
    for (int j = 0; j < 8; ++j) { v[j] = *(const f32x4*)(xrow + j * 256 + lane * 4); s += (v[j][0] * v[j][0] + v[j][1] * v[j][1]) + (v[j][2] * v[j][2] + v[j][3] * v[j][3]); }
    const float r = 1.0f / sqrtf(wave_sum(s) * (1.0f / DM) + EPS);
#pragma unroll
    for (int j = 0; j < 8; ++j) { const f32x4 g = *(const f32x4*)(gain + j * 256 + lane * 4);
        const float y0 = v[j][0] * r * g[0], y1 = v[j][1] * r * g[1], y2 = v[j][2] * r * g[2], y3 = v[j][3] * r * g[3];
        u32x2 w; w.x = pk_bf16(y0, y1); w.y = pk_bf16(y2, y3);
        *(u32x2*)(orow + j * 256 + lane * 4) = w;
        if (qrow) {
            float am = fmaxf(fmaxf(fabsf(y0), fabsf(y1)), fmaxf(fabsf(y2), fabsf(y3)));
            am = fmaxf(am, __shfl_xor(am, 1)); am = fmaxf(am, __shfl_xor(am, 2)); am = fmaxf(am, __shfl_xor(am, 4));
            const unsigned sb = mx_scale_byte(am); const float inv = mx_inv_scale(sb); const int chunk = 2 * j + (lane >> 5), kk = (lane & 31) * 4;
            *(unsigned*)(qrow + chunk * 128 + kk) = fp8x4(y0 * inv, y1 * inv, y2 * inv, y3 * inv);
            if ((lane & 7) == 0) qscl[chunk * 4 + (kk >> 5)] = (unsigned char)sb; } }
}

__device__ __forceinline__ void ssm_build_group(const Args& A, int g, LAS unsigned char* lds) {
    LAS float* AP = (LAS float*)lds;
    LAS float* BB = AP + 2 * 33 * 64 * 2;
    LAS float* CC = BB + 2 * 64 * 16 * 2;
    LAS float* KT = CC + 2 * 16 * 64 * 2;
    const int tid = threadIdx.x;
    for (int idx = tid; idx < 2 * 33 * 64; idx += NTHREADS) {
        const int d = idx / (33 * 64), rem = idx % (33 * 64), e = rem / 64, p = rem % 64;
        const float lr = A.in[d ? I_LRB : I_LRF][g * 64 + p], li = A.in[d ? I_LIB : I_LIF][g * 64 + p], dt = expf(A.in[d ? I_DTB : I_DTF][g]);
        const float mag = expf(lr * dt * (float)e), ang = li * dt * (float)e; float sn, cs; sincosf(ang, &sn, &cs);
        AP[idx * 2] = mag * cs; AP[idx * 2 + 1] = mag * sn;
    }
    for (int idx = tid; idx < 2 * 16 * 64; idx += NTHREADS) {
        const int d = idx / 1024, rem = idx % 1024;
        CC[idx * 2] = A.in[d ? I_CRB : I_CRF][g * 1024 + rem]; CC[idx * 2 + 1] = A.in[d ? I_CIB : I_CIF][g * 1024 + rem];
    }
    __syncthreads();
    for (int idx = tid; idx < 2 * 64 * 16; idx += NTHREADS) {
        const int d = idx / 1024, rem = idx % 1024, p = rem / 16;
        const float lr = A.in[d ? I_LRB : I_LRF][g * 64 + p], li = A.in[d ? I_LIB : I_LIF][g * 64 + p];
        const float ar = AP[((d * 33 + 1) * 64 + p) * 2], ai = AP[((d * 33 + 1) * 64 + p) * 2 + 1];
        const float den = lr * lr + li * li, fr = ((ar - 1.0f) * lr + ai * li) / den, fi = (ai * lr - (ar - 1.0f) * li) / den;
        const float bre = A.in[d ? I_BRB : I_BRF][g * 1024 + rem], bim = A.in[d ? I_BIB : I_BIF][g * 1024 + rem];
        BB[idx * 2] = fr * bre - fi * bim; BB[idx * 2 + 1] = fr * bim + fi * bre;
    }
    __syncthreads();
    for (int idx = tid; idx < 2 * 32 * 16; idx += NTHREADS) {
        const int d = idx / 512, rem = idx % 512, dl = rem / 16, o = rem % 16;
        float acc[16];
#pragma unroll
        for (int i = 0; i < 16; ++i) acc[i] = 0.f;
        for (int p = 0; p < 64; ++p) {
            const float cr = CC[((d * 16 + o) * 64 + p) * 2], ci = CC[((d * 16 + o) * 64 + p) * 2 + 1];
            const float ar = AP[((d * 33 + dl) * 64 + p) * 2], ai = AP[((d * 33 + dl) * 64 + p) * 2 + 1];
            const float xr = cr * ar - ci * ai, xi = cr * ai + ci * ar;
            const LAS float* bp = BB + ((d * 64 + p) * 16) * 2;
#pragma unroll
            for (int i = 0; i < 16; ++i) acc[i] += xr * bp[2 * i] - xi * bp[2 * i + 1];
        }
#pragma unroll
        for (int i = 0; i < 16; ++i) KT[((d * 32 + dl) * 16 + o) * 16 + i] = acc[i];
    }
    __syncthreads();
    bf16_t* Bt3 = (bf16_t*)(A.ws + WS_BT3) + (size_t)g * 512 * UEXT_LD;
    bf16_t* Wst = (bf16_t*)(A.ws + WS_WST) + (size_t)g * 256 * 512;
    const float* Dv = A.in[I_SSMD] + g * 16;
    for (int piece = tid; piece < 512 * 64; piece += NTHREADS) {
        const int n = piece >> 6, kc = piece & 63, tau = n >> 4, o = n & 15, s = kc >> 1, i0 = (kc & 1) * 8; float v[8];
#pragma unroll
        for (int j = 0; j < 8; ++j) { const int i = i0 + j; float x;
            if (s < tau) x = KT[((0 * 32 + (tau - s)) * 16 + o) * 16 + i];
            else if (s > tau) x = KT[((1 * 32 + (s - tau)) * 16 + o) * 16 + i];
            else x = KT[(o) * 16 + i] + KT[((32) * 16 + o) * 16 + i] + ((o == i) ? Dv[o] : 0.f);
            v[j] = x; }
        st8bf(Bt3 + (size_t)n * UEXT_LD + kc * 8, v);
    }
    for (int piece = tid; piece < 512 * 32; piece += NTHREADS) {
        const int n = piece >> 5, pc = piece & 31, tau = n >> 4, o = n & 15, d = pc >> 4, p0 = (pc & 15) * 4, e = d ? (32 - tau) : (tau + 1); float v[8];
#pragma unroll
        for (int j = 0; j < 4; ++j) { const int p = p0 + j;
            const float cr = CC[((d * 16 + o) * 64 + p) * 2], ci = CC[((d * 16 + o) * 64 + p) * 2 + 1];
            const float ar = AP[((d * 33 + e) * 64 + p) * 2], ai = AP[((d * 33 + e) * 64 + p) * 2 + 1];
            v[2 * j] = cr * ar - ci * ai; v[2 * j + 1] = -(cr * ai + ci * ar); }
        st8bf(Bt3 + (size_t)n * UEXT_LD + 512 + pc * 8, v);
    }
    for (int piece = tid; piece < 256 * 64; piece += NTHREADS) {
        const int n = piece >> 6, kc = piece & 63, tau = kc >> 1, i0 = (kc & 1) * 8, d = n >> 7, p = (n & 127) >> 1, c = n & 1, e = d ? tau : (31 - tau); float v[8];
        const float ar = AP[((d * 33 + e) * 64 + p) * 2], ai = AP[((d * 33 + e) * 64 + p) * 2 + 1];
#pragma unroll
        for (int j = 0; j < 8; ++j) { const float br = BB[((d * 64 + p) * 16 + i0 + j) * 2], bi = BB[((d * 64 + p) * 16 + i0 + j) * 2 + 1];
            v[j] = c ? (ar * bi + ai * br) : (ar * br - ai * bi); }
        st8bf(Wst + (size_t)n * 512 + kc * 8, v);
    }
    __syncthreads();
}

__global__ void __launch_bounds__(NTHREADS, 2) mk_fwd(Args A) {
    extern __shared__ __attribute__((aligned(16))) unsigned char lds_raw[];
    LAS unsigned char* lds = (LAS unsigned char*)lds_raw;
    const int tid = threadIdx.x, lane = tid & 63, wave = __builtin_amdgcn_readfirstlane(tid >> 6);
    const int G = gridDim.x, bx = blockIdx.x, vcu = (G % 8 == 0) ? (bx % 8) * (G / 8) + bx / 8 : bx;
    const int gw = vcu * NWAVES + wave, NGW = G * NWAVES;
    unsigned char* ws = A.ws;
    unsigned* ctl = (unsigned*)(ws + WS_CTL);
    volatile LAS unsigned* MISC = (volatile LAS unsigned*)(lds + MISC_OFF);
    LAS int* tstart = (LAS int*)(lds + LDSCTL_OFF);
    for (int u = tid; u < (LDS_BYTES - LDSCTL_OFF) / 4; u += NTHREADS) ((LAS unsigned*)(lds + LDSCTL_OFF))[u] = 0u;
    __syncthreads();
#if MK_FUSED
    XcdBarrier bar = xcd_barrier_post(ctl + CW_BAR, MISC + 8);
#define GRID_BAR() xcd_barrier(bar)
#else
#define GRID_BAR() do { } while (0)
#endif
    const int lo = A.ph_lo, hi_ = A.ph_hi;
#ifndef PH_MASK
#define PH_MASK 0x7fff
#endif
#define IN(k) (((PH_MASK >> (k)) & 1) && lo <= (k) && (k) < hi_)
#define BOTH(k) (IN(k) && IN((k) + 1))
#define REP(k) for (int rep_ = 0; rep_ < ((((DBL_MASK) >> (k)) & 1) ? 2 : 1); ++rep_)

    bf16_t* Wt_in = (bf16_t*)(ws + WS_WIN); bf16_t* Wt_glu = (bf16_t*)(ws + WS_WGLU); bf16_t* Wt_ao = (bf16_t*)(ws + WS_WAO); bf16_t* Wt_out = (bf16_t*)(ws + WS_WOUT);
    bf16_t* Wt_e1 = (bf16_t*)(ws + WS_WE1); bf16_t* Wt_e2 = (bf16_t*)(ws + WS_WE2);
    bf16_t* XN = (bf16_t*)(ws + WS_XN); bf16_t* UEXT = (bf16_t*)(ws + WS_UEXT); bf16_t* QB = (bf16_t*)(ws + WS_Q); bf16_t* KB = (bf16_t*)(ws + WS_K); bf16_t* VB = (bf16_t*)(ws + WS_V);
    bf16_t* GS = (bf16_t*)(ws + WS_GS); bf16_t* GA = (bf16_t*)(ws + WS_GA); float* SB = (float*)(ws + WS_S); bf16_t* YB = (bf16_t*)(ws + WS_Y);
    bf16_t* OP = (bf16_t*)(ws + WS_OP); bf16_t* OB = (bf16_t*)(ws + WS_O); bf16_t* T2 = (bf16_t*)(ws + WS_T2); bf16_t* MRG = (bf16_t*)(ws + WS_MRG); bf16_t* HN = (bf16_t*)(ws + WS_HN);
    bf16_t* ACT = (bf16_t*)(ws + WS_ACT); bf16_t* YS = (bf16_t*)(ws + WS_YS);
    bf16_t* XNM = (bf16_t*)(ws + WS_MISC + MISC_XNM); float* UM = (float*)(ws + WS_MISC + MISC_UM); bf16_t* KM = (bf16_t*)(ws + WS_MISC + MISC_KM); bf16_t* VM = (bf16_t*)(ws + WS_MISC + MISC_VM);
    bf16_t* WFH = (bf16_t*)(ws + WS_MISC + 1024 * 1024); bf16_t* WFL = (bf16_t*)(ws + WS_MISC + 1280 * 1024);
    u32x2* TOKR = (u32x2*)(ws + WS_ROUTE + RT_E); int* TOK_SLOT = (int*)(ws + WS_ROUTE + RT_SLOT);
    int* SLOT_TOK = (int*)(ws + WS_ROUTE + RT_STOK); float* SLOT_GATE = (float*)(ws + WS_ROUTE + RT_SGATE);
    bf16_t* H1B = (bf16_t*)(ws + WS_T2);
    unsigned char* W1Q = (unsigned char*)(ws + WS_WE1); unsigned char* W2Q = (unsigned char*)(ws + WS_WE2); unsigned char* HNQ = (unsigned char*)(ws + WS_HN); unsigned char* ACTQ = (unsigned char*)(ws + WS_ACT);
    unsigned char* XNQ = (unsigned char*)(ws + WS_XNQ); unsigned char* XNS = (unsigned char*)(ws + WS_XNS); unsigned char* WGQ = (unsigned char*)(ws + WS_WGQ); unsigned char* WGS = (unsigned char*)(ws + WS_WGS);
    unsigned char* WOQ = (unsigned char*)(ws + WS_WOUT); unsigned char* WOS = (unsigned char*)(ws + WS_WOUT + 4 * MiB); unsigned char* MRGQ = (unsigned char*)(ws + WS_MRG); unsigned char* MRGS = (unsigned char*)(ws + WS_MRG + 32 * MiB);
    unsigned char* HNQL = (unsigned char*)(ws + WS_HNL); unsigned char* HNSL = (unsigned char*)(ws + WS_HNLS);
    unsigned char* YSQ = (unsigned char*)(ws + WS_YS); unsigned char* YSS = (unsigned char*)(ws + WS_YS + 160 * MiB);
    unsigned char* HNS = (unsigned char*)(ws + WS_YF); unsigned char* ACTS = (unsigned char*)(ws + WS_YF + 2 * MiB); unsigned char* W1S = (unsigned char*)(ws + WS_YF + 8 * MiB); unsigned char* W2S = (unsigned char*)(ws + WS_YF + 16 * MiB);

    if (IN(0)) REP(0) {
        LAS float* scr = (LAS float*)(lds + wave * 16896);
        constexpr int I_IN = (DM / 64) * (4096 / 64), I_ING = (DM / 128) * (4096 / 32), I_GLU = (SSMW / 64) * (4096 / 64), I_AO = (1024 / 64) * (DM / 64), I_OUT = (DM / 128) * (DM / 32);
        constexpr int I_E1 = MOE_MX ? (DM / 128) * (4096 / 32) : (DM / 64) * (4096 / 64), I_E2 = (MOE_MX == 1) ? (DFF / 128) * (DM / 32) : (DFF / 64) * (DM / 64);
        constexpr int NITEMS = I_IN + I_ING + I_GLU + I_AO + I_OUT + NEXP * (I_E1 + I_E2);
        for (int g = bx; g < NGRP; g += G) ssm_build_group(A, g, lds);
        for (int rnd = 0;; ++rnd) {
            if (tid == 0) MISC[16 + (rnd & 1)] = __hip_atomic_fetch_add(ctl + CW_Q0 + rep_, 16u, __ATOMIC_RELAXED, __HIP_MEMORY_SCOPE_AGENT);
            __syncthreads();
            const int base = (int)MISC[16 + (rnd & 1)]; if (base >= NITEMS) break;
          for (int sub = 0; sub < 2; ++sub) {
            const int it = base + sub * 8 + wave; if (it >= NITEMS) break;
            int r = it;
            if (r < I_IN) { transpose_item(A.in[I_WIN], DM, 4096, Wt_in, RmId(), scr, r, lane, INCOLS); continue; } r -= I_IN;
            if (r < I_ING) { transpose_item_q(A.in[I_WIN] + 4096, DM, 4096, WGQ, WGS, RmId(), scr, r, lane, INCOLS); continue; } r -= I_ING;
            if (r < I_GLU) { transpose_item(A.in[I_WGLU], SSMW, 4096, Wt_glu, RmGlu(), scr, r, lane); continue; } r -= I_GLU;
            if (r < I_AO) { transpose_item(A.in[I_WAO], 1024, DM, Wt_ao, RmId(), scr, r, lane); continue; } r -= I_AO;
            if (r < I_OUT) { transpose_item_q(A.in[I_WOUT], DM, DM, WOQ, WOS, RmId(), scr, r, lane); continue; } r -= I_OUT;
#if MOE_MX
            if (r < NEXP * I_E1) { const int e = r / I_E1; transpose_item_q(A.in[I_WE1] + (size_t)e * DM * 4096, DM, 4096, W1Q + (size_t)e * 4096 * DM, W1S + (size_t)e * 4096 * 64, RmE1(), scr, r % I_E1, lane); continue; } r -= NEXP * I_E1;
#if MOE_MX == 1
            { const int e = r / I_E2; transpose_item_q(A.in[I_WE2] + (size_t)e * DFF * DM, DFF, DM, W2Q + (size_t)e * DM * DFF, W2S + (size_t)e * DM * 64, RmId(), scr, r % I_E2, lane); }
#else
            { const int e = r / I_E2; transpose_item(A.in[I_WE2] + (size_t)e * DFF * DM, DFF, DM, Wt_e2 + (size_t)e * DM * DFF, RmId(), scr, r % I_E2, lane); }
#endif
#else
            if (r < NEXP * I_E1) { const int e = r / I_E1; transpose_item(A.in[I_WE1] + (size_t)e * DM * 4096, DM, 4096, Wt_e1 + (size_t)e * 4096 * DM, RmE1(), scr, r % I_E1, lane); continue; } r -= NEXP * I_E1;
            { const int e = r / I_E2; transpose_item(A.in[I_WE2] + (size_t)e * DFF * DM, DFF, DM, Wt_e2 + (size_t)e * DM * DFF, RmId(), scr, r % I_E2, lane); }
#endif
          }
        }
        for (int m = gw; m < MTOK + NMETA; m += NGW) {
            if (m < MTOK) rms_row_bf16(A.in[I_X] + (size_t)m * DM, A.in[I_GMIX], XN + (size_t)m * DM, lane, XNQ + (size_t)m * DM, XNS + (size_t)m * 64);
            else rms_row_bf16(A.in[I_META] + (size_t)(m - MTOK) * DM, A.in[I_GMIX], XNM + (size_t)(m - MTOK) * DM, lane);
        }
        for (int i = gw * 64 + lane; i < 128 * 64 * 8; i += NGW * 64) { const int ks = i >> 9, ln = (i >> 3) & 63, q = i & 7; const int e = ln & 31, k = ks * 16 + (ln >> 5) * 8 + q;
            const float w = A.in[I_WR][k * NEXP + e] * A.in[I_GMOE][k]; const unsigned hb = pk_bf16(w, 0.f) & 0xffffu; const float lo = w - __uint_as_float(hb << 16);
            WFH[i] = (bf16_t)hb; WFL[i] = (bf16_t)(pk_bf16(lo, 0.f) & 0xffffu); }
        for (int i = gw * 64 + lane; i < 2 * 48 * 128; i += NGW * 64) { const int w = i / (48 * 128), rem = i % (48 * 128); bf16_t* base = w ? VM : KM; *(u32x4*)(base + 16 * 1024 + rem * 8) = (u32x4){0u, 0u, 0u, 0u}; }
        if (BOTH(0)) GRID_BAR();
    }

    if (IN(1)) REP(1) {
        for (int ci = gw; ci < 3072; ci += NGW) {
            const int n = ci < 1024 ? ci : ci + 1024;
            float acc[16];
#pragma unroll
            for (int r = 0; r < 16; ++r) acc[r] = 0.f;
#pragma unroll
            for (int j = 0; j < 4; ++j) { float wv[8]; ld8bf(Wt_in + (size_t)n * DM + j * 512 + lane * 8, wv);
#pragma unroll
                for (int r = 0; r < 16; ++r) { float xv[8]; ld8bf(XNM + (size_t)r * DM + j * 512 + lane * 8, xv);
#pragma unroll
                    for (int q = 0; q < 8; ++q) acc[r] += wv[q] * xv[q]; } }
#pragma unroll
            for (int r = 0; r < 16; ++r) acc[r] = wave_sum(acc[r]);
            if (lane < 16) { float v = acc[0];
#pragma unroll
                for (int r = 1; r < 16; ++r) v = (lane == r) ? acc[r] : v;
                if (n < 1024) UM[lane * 1024 + n] = v;
                else if (n < 3072) KM[lane * 1024 + (n - 2048)] = (bf16_t)(pk_bf16(v, 0.f) & 0xffffu);
                else VM[lane * 1024 + (n - 3072)] = (bf16_t)(pk_bf16(v, 0.f) & 0xffffu); }
        }
        { pg8::RegOrder S; S.init(XN, Wt_in, DM, DM, MTOK, 4096, G, bx);
          EpiInProj E{UEXT, QB, KB, VB, GS, GA};
          pg8::gemm_run<EpiInProj, pg8::RegOrder, false>(lds, pg8::Dims{DM, DM, DM}, S, E); }
        { pg8::RegOrderMx S; S.init(XNQ, WGQ, DM / 2, DM / 2, MTOK, 4096, G, bx); S.sA = (const unsigned*)XNS; S.sB = (const unsigned*)WGS; S.nt = 16;
          EpiGates E{GS, GA};
          pg8::gemm_phase_mx<EpiGates, pg8::RegOrderMx, false>(lds, pg8::Dims{DM / 2, DM / 2, DM / 2}, S, E); }
        if (BOTH(1)) GRID_BAR();
    }

    auto norm_pass = [&](const int wv, const int NWV, LAS unsigned* nred) {
            float mq0 = 0.f, mq1 = 0.f, mk0 = 0.f, mk1 = 0.f;
#pragma unroll 2
            for (int m = wv; m < MTOK + NMETA; m += NWV) {
                const bool meta = m >= MTOK; float kk[16], qq[16];
                { float t0[8], t1[8]; const bf16_t* kp = meta ? KM + (size_t)(m - MTOK) * 1024 + lane * 16 : KB + (size_t)m * 1024 + lane * 16; ld8bf(kp, t0); ld8bf(kp + 8, t1);
#pragma unroll
                  for (int j = 0; j < 8; ++j) { kk[j] = t0[j]; kk[8 + j] = t1[j]; } }
                if (!meta) { float t0[8], t1[8]; const bf16_t* qp = QB + (size_t)m * 1024 + lane * 16; ld8bf(qp, t0); ld8bf(qp + 8, t1);
#pragma unroll
                  for (int j = 0; j < 8; ++j) { qq[j] = t0[j]; qq[8 + j] = t1[j]; } }
                else {
#pragma unroll
                  for (int j = 0; j < 16; ++j) qq[j] = 0.f; }
                float sk = 0.f, sq = 0.f;
#pragma unroll
                for (int j = 0; j < 16; ++j) { sk += kk[j] * kk[j]; sq += qq[j] * qq[j]; }
                sk += __shfl_xor(sk, 1); sk += __shfl_xor(sk, 2); sq += __shfl_xor(sq, 1); sq += __shfl_xor(sq, 2);
                if (meta) { mk0 = fmaxf(mk0, sk); mk1 = fmaxf(mk1, sk); }
                else if (m < SEQ) { mk0 = fmaxf(mk0, sk); mq0 = fmaxf(mq0, sq); } else { mk1 = fmaxf(mk1, sk); mq1 = fmaxf(mq1, sq); }
            }
            if ((lane & 3) == 0) { const int hc = lane >> 2;
                __hip_atomic_fetch_max(nred + hc, __float_as_uint(mq0), __ATOMIC_RELAXED, __HIP_MEMORY_SCOPE_WORKGROUP); __hip_atomic_fetch_max(nred + 16 + hc, __float_as_uint(mq1), __ATOMIC_RELAXED, __HIP_MEMORY_SCOPE_WORKGROUP);
                __hip_atomic_fetch_max(nred + 32 + hc, __float_as_uint(mk0), __ATOMIC_RELAXED, __HIP_MEMORY_SCOPE_WORKGROUP); __hip_atomic_fetch_max(nred + 48 + hc, __float_as_uint(mk1), __ATOMIC_RELAXED, __HIP_MEMORY_SCOPE_WORKGROUP); }

    };
    const bool norms_in_p2 = G > 2 * NGRP;
    if (IN(2)) REP(2) {
#if NAIVE_SSM
        float* YF = (float*)(ws + WS_YF);
        for (int c = gw; c < NB * NGRP; c += NGW) {
            const int g = c & 63, bb = c >> 6, p = lane;
            for (int d = 0; d < 2; ++d) {
                const float lr = A.in[d ? I_LRB : I_LRF][g * 64 + p], li = A.in[d ? I_LIB : I_LIF][g * 64 + p], dt = expf(A.in[d ? I_DTB : I_DTF][g]);
                const float mag = expf(lr * dt); float sn, cs; sincosf(li * dt, &sn, &cs); const float ar = mag * cs, ai = mag * sn;
                const float den = lr * lr + li * li, fr = ((ar - 1.0f) * lr + ai * li) / den, fi = (ai * lr - (ar - 1.0f) * li) / den;
                float br[16], bi[16], cr[16], ci[16];
#pragma unroll
                for (int i = 0; i < 16; ++i) { const float bre = A.in[d ? I_BRB : I_BRF][(g * 64 + p) * 16 + i], bim = A.in[d ? I_BIB : I_BIF][(g * 64 + p) * 16 + i];
                    br[i] = fr * bre - fi * bim; bi[i] = fr * bim + fi * bre; cr[i] = A.in[d ? I_CRB : I_CRF][(g * 16 + i) * 64 + p]; ci[i] = A.in[d ? I_CIB : I_CIF][(g * 16 + i) * 64 + p]; }
                float hr = 0.f, hi2 = 0.f;
                if (d == 0) for (int s = 0; s < 16; ++s) { float dr = 0.f, di = 0.f;
#pragma unroll
                    for (int i = 0; i < 16; ++i) { const float uv = UM[s * 1024 + g * 16 + i]; dr += uv * br[i]; di += uv * bi[i]; }
                    const float nr = ar * hr - ai * hi2 + dr, ni = ar * hi2 + ai * hr + di; hr = nr; hi2 = ni; }
                for (int tt = 0; tt < SEQ; ++tt) {
                    const int t = d ? (SEQ - 1 - tt) : tt;
                    float uv[16]; { float t0[8], t1[8]; const bf16_t* up = UEXT + ((size_t)(g * GROWS + bb * NCHUNK + (t >> 5)) * UEXT_LD + (t & 31) * 16); ld8bf(up, t0); ld8bf(up + 8, t1);
#pragma unroll
                        for (int i = 0; i < 8; ++i) { uv[i] = t0[i]; uv[8 + i] = t1[i]; } }
                    float dr = 0.f, di = 0.f;
#pragma unroll
                    for (int i = 0; i < 16; ++i) { dr += uv[i] * br[i]; di += uv[i] * bi[i]; }
                    const float nr = ar * hr - ai * hi2 + dr, ni = ar * hi2 + ai * hr + di; hr = nr; hi2 = ni;
                    float yv = 0.f;
#pragma unroll
                    for (int o = 0; o < 16; ++o) { const float s = wave_sum(hr * cr[o] - hi2 * ci[o]); yv = (lane == o) ? s : yv; }
                    if (lane < 16) {
                        const size_t m = (size_t)bb * SEQ + t;
                        if (d == 0) YF[m * SSMW + g * 16 + lane] = yv;
                        else { float uo = uv[0];
#pragma unroll
                            for (int o = 1; o < 16; ++o) uo = (lane == o) ? uv[o] : uo;
                            const float tot = YF[m * SSMW + g * 16 + lane] + yv + A.in[I_SSMD][g * 16 + lane] * uo;
                            YB[m * SSMW + g * 16 + lane] = (bf16_t)(pk_bf16(gelu_tanh(tot), 0.f) & 0xffffu); }
                    }
                }
            }
        }
#else
        pg8::SsmOrder S{(const char*)UEXT, (const char*)(ws + WS_WST), 1, 512, 256, G, vcu};
        EpiS1 E{SB};
        pg8::gemm_run<EpiS1, pg8::SsmOrder, false>(lds, pg8::Dims{UEXT_LD, 512, 512}, S, E);
        if (norms_in_p2 && vcu >= 2 * NGRP) {
            LAS unsigned* nred2 = (LAS unsigned*)lds;
            if (tid < 64) nred2[tid] = 0u;
            __syncthreads();
            norm_pass((vcu - 2 * NGRP) * NWAVES + wave, (G - 2 * NGRP) * NWAVES, nred2);
            __syncthreads();
            if (tid < 64 && nred2[tid]) atomicMax(ctl + CW_NRM + tid, nred2[tid]);
        }
#endif
        if (BOTH(2)) GRID_BAR();
    }

    if (IN(3)) REP(3) {
#if !NAIVE_SSM
        LAS unsigned* nred = (LAS unsigned*)lds;
        if (tid < 64) nred[tid] = 0u;
        __syncthreads();
        if (wave > 0 && !norms_in_p2) norm_pass((wave - 1) * G + vcu, 7 * G, nred);
        LAS float* SE = (LAS float*)(lds + 1024);
        for (int c = vcu; c < 2 * NB * NGRP; c += G) {
            const int g = c & 63, bb = (c >> 6) & 1, d = c >> 7, p = lane;
            const float lr = A.in[d ? I_LRB : I_LRF][g * 64 + p], li = A.in[d ? I_LIB : I_LIF][g * 64 + p], dt = expf(A.in[d ? I_DTB : I_DTF][g]);
            float sn, cs; const float mag32 = expf(lr * dt * 32.0f); sincosf(li * dt * 32.0f, &sn, &cs); const float a32r = mag32 * cs, a32i = mag32 * sn;
            const float* Sp = SB + ((size_t)(g * GROWS + bb * NCHUNK) * 256 + d * 128 + 2 * p);
            bf16_t* Cp = UEXT + ((size_t)(g * GROWS + bb * NCHUNK) * UEXT_LD + 512 + d * 128 + 2 * p);
            const int c0 = wave * 32;
            f32x2 sv[32];
#pragma unroll
            for (int k = 0; k < 32; ++k) { const int cc = d ? (NCHUNK - 1 - (c0 + k)) : (c0 + k); sv[k] = *(const f32x2*)(Sp + (size_t)cc * 256); }
            if (wave == 0) {
                float hr = 0.f, hi2 = 0.f;
                if (d == 0) {
                    const float mag = expf(lr * dt); sincosf(li * dt, &sn, &cs); const float ar = mag * cs, ai = mag * sn;
                    const float den = lr * lr + li * li, fr = ((ar - 1.0f) * lr + ai * li) / den, fi = (ai * lr - (ar - 1.0f) * li) / den;
                    float br[16], bi[16];
#pragma unroll
                    for (int i = 0; i < 16; ++i) { const float bre = A.in[I_BRF][(g * 64 + p) * 16 + i], bim = A.in[I_BIF][(g * 64 + p) * 16 + i]; br[i] = fr * bre - fi * bim; bi[i] = fr * bim + fi * bre; }
                    for (int s_ = 0; s_ < 16; ++s_) { float dr = 0.f, di = 0.f;
#pragma unroll
                        for (int i = 0; i < 16; ++i) { const float uv = UM[s_ * 1024 + g * 16 + i]; dr += uv * br[i]; di += uv * bi[i]; }
                        const float nr = ar * hr - ai * hi2 + dr, ni = ar * hi2 + ai * hr + di; hr = nr; hi2 = ni; }
                }
                SE[(8 * 64 + lane) * 2] = hr; SE[(8 * 64 + lane) * 2 + 1] = hi2;
            }
            f32x2 lp[32]; { float xr = 0.f, xi = 0.f;
#pragma unroll
                for (int k = 0; k < 32; ++k) { lp[k] = (f32x2){xr, xi}; const float nr = a32r * xr - a32i * xi + sv[k][0], ni = a32r * xi + a32i * xr + sv[k][1]; xr = nr; xi = ni; }
                SE[(wave * 64 + lane) * 2] = xr; SE[(wave * 64 + lane) * 2 + 1] = xi; }
            __syncthreads();
            float kr = a32r, ki = a32i;
#pragma unroll
            for (int q = 0; q < 5; ++q) { const float t_ = kr * kr - ki * ki; ki = 2.0f * kr * ki; kr = t_; }
            float cr = SE[(8 * 64 + lane) * 2], ci = SE[(8 * 64 + lane) * 2 + 1];
            for (int w = 0; w < wave; ++w) { const float er = SE[(w * 64 + lane) * 2], ei = SE[(w * 64 + lane) * 2 + 1]; const float nr = kr * cr - ki * ci + er, ni = kr * ci + ki * cr + ei; cr = nr; ci = ni; }
            { float pr = 1.f, pi_ = 0.f;
#pragma unroll
                for (int k = 0; k < 32; ++k) { const int cc = d ? (NCHUNK - 1 - (c0 + k)) : (c0 + k);
                    *(unsigned*)(Cp + (size_t)cc * UEXT_LD) = pk_bf16(lp[k][0] + (pr * cr - pi_ * ci), lp[k][1] + (pr * ci + pi_ * cr));
                    const float t_ = pr * a32r - pi_ * a32i; pi_ = pr * a32i + pi_ * a32r; pr = t_; } }
            __syncthreads();
        }
        __syncthreads();
        if (tid < 64 && nred[tid]) atomicMax(ctl + CW_NRM + tid, nred[tid]);
#endif
        if (BOTH(3)) GRID_BAR();
    }

    if (IN(4)) REP(4) {
#if !NAIVE_SSM
        pg8::SsmOrder S{(const char*)UEXT, (const char*)(ws + WS_BT3), 2, UEXT_LD, 512, G, vcu};
        EpiS3 E{YB};
        pg8::gemm_run<EpiS3, pg8::SsmOrder, false>(lds, pg8::Dims{UEXT_LD, UEXT_LD, UEXT_LD}, S, E);
#endif
        if (BOTH(4)) GRID_BAR();
    }

    if (IN(5)) REP(5) {
#if NAIVE_ATTN
        for (int it = bx * NTHREADS + tid; it < NB * NHC * SEQ; it += G * NTHREADS) {
            const int i = it & (SEQ - 1), hc = (it >> 13) & 15, bb = it >> 17, h = hc >> 1;
            const float nslope = -exp2f(-(float)(h + 1)) * LOG2E;
            float q[64], o[128];
#pragma unroll
            for (int d8 = 0; d8 < 8; ++d8) { float t[8]; ld8bf(QB + ((size_t)(bb * SEQ + i)) * 1024 + hc * 64 + d8 * 8, t);
#pragma unroll
                for (int j = 0; j < 8; ++j) q[d8 * 8 + j] = t[j]; }
#pragma unroll
            for (int j = 0; j < 128; ++j) o[j] = 0.f;
            float mx = -1e30f, l = 0.f;
            for (int jj = -NMETA; jj < SEQ; ++jj) {
                const bf16_t* kp = (jj < 0) ? KM + (size_t)(jj + NMETA) * 1024 + hc * 64 : KB + ((size_t)(bb * SEQ + jj)) * 1024 + hc * 64;
                const bf16_t* vp = (jj < 0) ? VM + (size_t)(jj + NMETA) * 1024 + h * 128 : VB + ((size_t)(bb * SEQ + jj)) * 1024 + h * 128;
                float s = 0.f;
#pragma unroll
                for (int d8 = 0; d8 < 8; ++d8) { float t[8]; ld8bf(kp + d8 * 8, t);
#pragma unroll
                    for (int j = 0; j < 8; ++j) s += q[d8 * 8 + j] * t[j]; }
                if (jj >= 0) s += nslope * fabsf((float)(i - jj));
                if (s > mx) { const float sc = exp2f(mx - s); l *= sc;
#pragma unroll
                    for (int j = 0; j < 128; ++j) o[j] *= sc;
                    mx = s; }
                const float pp = exp2f(s - mx); l += pp;
#pragma unroll
                for (int d8 = 0; d8 < 16; ++d8) { float t[8]; ld8bf(vp + d8 * 8, t);
#pragma unroll
                    for (int j = 0; j < 8; ++j) o[d8 * 8 + j] += pp * t[j]; }
            }
            const float rl = 1.0f / l;
#pragma unroll
            for (int d8 = 0; d8 < 16; ++d8) { float t[8];
#pragma unroll
                for (int j = 0; j < 8; ++j) t[j] = o[d8 * 8 + j] * rl;
                st8bf(OP + ((size_t)(bb * SEQ + i)) * 2048 + hc * 128 + d8 * 8, t); }
        }
#else
        for (int rnd = 0;; ++rnd) {
            if (tid == 0) MISC[20 + (rnd & 1)] = rnd == 0 ? (unsigned)bx : (unsigned)G + __hip_atomic_fetch_add(ctl + CW_AQ + rep_, 1u, __ATOMIC_RELAXED, __HIP_MEMORY_SCOPE_AGENT);
            __syncthreads();
            const int u = __builtin_amdgcn_readfirstlane((int)MISC[20 + (rnd & 1)]); if (u >= NB * NHC * 32) break;
            const int h = 7 - (u >> 7), bb = (u >> 6) & 1, c2 = (u >> 5) & 1, qb = u & 31, hc = 2 * h + c2, q0 = qb * 256;
            const float sl2 = exp2f(-(float)(h + 1)) * LOG2E, nslope = -sl2;
            const float qn2 = __uint_as_float(__hip_atomic_load(ctl + CW_NRM + bb * 16 + hc, __ATOMIC_RELAXED, __HIP_MEMORY_SCOPE_AGENT)), kn2 = __uint_as_float(__hip_atomic_load(ctl + CW_NRM + 32 + bb * 16 + hc, __ATOMIC_RELAXED, __HIP_MEMORY_SCOPE_AGENT));
            const float Mb = sqrtf(qn2) * sqrtf(kn2) * 1.001f; const float wf = fminf((160.0f + 2.0f * Mb) / sl2 + 1.0f, 16384.0f); const int Wd = (int)wf + 1;
            const int klo = (q0 - Wd) < 0 ? 0 : q0 - Wd, khi = (q0 + 255 + Wd) > SEQ - 1 ? SEQ - 1 : q0 + 255 + Wd;
            int t_lo = 1 + (klo >> 6), t_hi = 1 + (khi >> 6); int n = 2 + t_hi - t_lo;
            if ((n & 1) == 0) { if (t_lo > 1) --t_lo; else ++t_hi; ++n; }
            t_lo = __builtin_amdgcn_readfirstlane(t_lo); n = __builtin_amdgcn_readfirstlane(n);
            att::attn_unit(QB + ((size_t)(bb * SEQ + q0)) * 1024 + hc * 64, KB + (size_t)bb * SEQ * 1024 + hc * 64, VB + (size_t)bb * SEQ * 1024 + h * 128,
                           KM + hc * 64, VM + h * 128, OP + ((size_t)(bb * SEQ + q0)) * 2048 + hc * 128, q0, nslope, (char*)lds_raw, t_lo, n);
        }
#endif
        if (BOTH(5)) GRID_BAR();
    }

    if (IN(6)) REP(6) {
        float sa = A.in[I_LQ1][lane] * A.in[I_LK1][lane], sb = A.in[I_LQ2][lane] * A.in[I_LK2][lane];
        sa = wave_sum(sa); sb = wave_sum(sb);
        const float lam = expf(sa) - expf(sb) + 0.2f;
        const int h = lane >> 3, j0 = (lane & 7) * 16;
        float gsub[16];
#pragma unroll
        for (int j = 0; j < 16; ++j) gsub[j] = A.in[I_SUBG][j0 + j] * 0.8f;
        for (int m = gw; m < MTOK; m += NGW) {
            const bf16_t* p0 = OP + (size_t)m * 2048 + (2 * h) * 128 + j0; const bf16_t* p1 = p0 + 128;
            float a0[8], a1[8], b0[8], b1[8]; ld8bf(p0, a0); ld8bf(p0 + 8, a1); ld8bf(p1, b0); ld8bf(p1 + 8, b1);
            float dv[16]; float ss = 0.f;
#pragma unroll
            for (int j = 0; j < 8; ++j) { dv[j] = a0[j] - lam * b0[j]; dv[8 + j] = a1[j] - lam * b1[j]; }
#pragma unroll
            for (int j = 0; j < 16; ++j) ss += dv[j] * dv[j];
            ss += __shfl_xor(ss, 1); ss += __shfl_xor(ss, 2); ss += __shfl_xor(ss, 4);
            const float r = 1.0f / sqrtf(ss * (1.0f / 128.0f) + EPS);
            float y0[8], y1[8];
#pragma unroll
            for (int j = 0; j < 8; ++j) { y0[j] = dv[j] * r * gsub[j]; y1[j] = dv[8 + j] * r * gsub[8 + j]; }
            st8bf(OB + (size_t)m * 1024 + h * 128 + j0, y0); st8bf(OB + (size_t)m * 1024 + h * 128 + j0 + 8, y1);
        }
        if (BOTH(6)) GRID_BAR();
    }

    if (IN(7)) REP(7) {
        pg8::RegOrder S; S.init(OB, Wt_ao, 1024, 1024, MTOK, DM, G, bx);
        EpiAO E{GA, T2};
        pg8::gemm_run<EpiAO, pg8::RegOrder, false>(lds, pg8::Dims{1024, 1024, 1024}, S, E);
        if (BOTH(7)) GRID_BAR();
    }
    if (IN(8)) REP(8) {
        pg8::RegOrder S; S.init(YB, Wt_glu, SSMW, SSMW, MTOK, 4096, G, bx);
        EpiGLUQ E{GS, T2, MRGQ, MRGS};
        pg8::gemm_run<EpiGLUQ, pg8::RegOrder, false>(lds, pg8::Dims{SSMW, SSMW, SSMW}, S, E);
        if (BOTH(8)) GRID_BAR();
    }
    if (IN(9)) REP(9) {
        pg8::RegOrderMx S; S.init(MRGQ, WOQ, DM / 2, DM / 2, MTOK, DM, G, bx); S.sA = (const unsigned*)MRGS; S.sB = (const unsigned*)WOS; S.nt = 16;
        EpiOut E{A.in[I_X], H1B};
        pg8::gemm_phase_mx<EpiOut, pg8::RegOrderMx, false>(lds, pg8::Dims{DM / 2, DM / 2, DM / 2}, S, E);
        if (BOTH(9)) GRID_BAR();
    }

    if (IN(10)) REP(10) {
        const int rho = lane >> 4, l16 = lane & 15, kofs = 16 * l16 + 4 * rho;
        LAS float* PL = (LAS float*)lds;
        LAS unsigned* lcnt = (LAS unsigned*)(lds + 131072); LAS unsigned* lbase = lcnt + NEXP;
        if (tid < NEXP) lcnt[tid] = 0u;
        for (int rd = 0; rd * NGW < MTOK / 4; ++rd) {
            const int mg = rd * NGW + gw; const bool act = mg < MTOK / 4;
            u32x2 raw[4][8];
#pragma unroll
            for (int t = 0; t < 4; ++t)
#pragma unroll
                for (int j = 0; j < 8; ++j) raw[t][j] = *(const u32x2*)(H1B + (size_t)((act ? mg : 0) * 4 + t) * DM + j * 256 + kofs);
            {
                const int r32 = lane & 31, hi = lane >> 5; const int tokbase = (act ? mg - wave : 0) * 4;
                const bf16_t* hb = H1B + (size_t)(tokbase + r32) * DM + wave * 256 + hi * 8;
                const bf16_t* wfh = WFH + ((size_t)(wave * 16) * 64 + lane) * 8; const bf16_t* wfl = WFL + ((size_t)(wave * 16) * 64 + lane) * 8;
                f32x16 pacc = {};
#pragma unroll 8
                for (int ks = 0; ks < 16; ++ks) {
                    const bf16x8 bfr = *reinterpret_cast<const bf16x8*>(hb + ks * 16);
                    const bf16x8 ah = *reinterpret_cast<const bf16x8*>(wfh + (size_t)ks * 512), al = *reinterpret_cast<const bf16x8*>(wfl + (size_t)ks * 512);
                    pacc = __builtin_amdgcn_mfma_f32_32x32x16_bf16(ah, bfr, pacc, 0, 0, 0);
                    pacc = __builtin_amdgcn_mfma_f32_32x32x16_bf16(al, bfr, pacc, 0, 0, 0);
                }
#pragma unroll
                for (int q = 0; q < 4; ++q) *(LAS f32x4*)(PL + ((wave * 32 + r32) * 36 + 8 * q + 4 * hi)) = (f32x4){pacc[4 * q], pacc[4 * q + 1], pacc[4 * q + 2], pacc[4 * q + 3]};
            }
            float rr[4];
#pragma unroll
            for (int t = 0; t < 4; ++t) {
                float s = 0.f;
#pragma unroll
                for (int j = 0; j < 8; ++j) { const u32x2 hw = raw[t][j]; const float a0 = bf_lo(hw.x), a1 = bf_hi(hw.x), a2 = bf_lo(hw.y), a3 = bf_hi(hw.y); s += (a0 * a0 + a1 * a1) + (a2 * a2 + a3 * a3); }
                rr[t] = 1.0f / sqrtf(wave_sum(s) * (1.0f / DM) + EPS);
            }
            float mylg[4];
            { const int r32 = lane & 31, hi = lane >> 5;
                __syncthreads();
                const float be = A.in[I_BR][r32];
#pragma unroll
                for (int t = 0; t < 4; ++t) { float sm = 0.f;
#pragma unroll
                    for (int pw = 0; pw < 8; ++pw) sm += PL[(pw * 32 + 4 * wave + t) * 36 + r32];
                    mylg[t] = hi ? -3.0e38f : fmaf(rr[t], sm, be); }
            }
            int sel_e[4], sel_r[4]; float sel_g[4];
#pragma unroll
            for (int t = 0; t < 4; ++t) {
                float tv[4]; int ti[4]; float lg = mylg[t];
#pragma unroll
                for (int k = 0; k < 4; ++k) { float bv = lg; int bi = lane;
                    wave_argmax_dpp(bv, bi);
                    tv[k] = bv; ti[k] = bi; if (lane == bi) lg = -3.0e38f; }
                const float e1 = expf(tv[1] - tv[0]), e2 = expf(tv[2] - tv[0]), e3 = expf(tv[3] - tv[0]); const float inv = 1.0f / (1.0f + e1 + e2 + e3);
                sel_e[t] = lane == 0 ? ti[0] : lane == 1 ? ti[1] : lane == 2 ? ti[2] : ti[3];
                sel_g[t] = (lane == 0 ? 1.0f : lane == 1 ? e1 : lane == 2 ? e2 : e3) * inv;
                sel_r[t] = 0;
            }
            if (act && lane < 4) {
#pragma unroll
                for (int t = 0; t < 4; ++t) sel_r[t] = (int)__hip_atomic_fetch_add((LAS unsigned*)(lcnt + sel_e[t]), 1u, __ATOMIC_RELAXED, __HIP_MEMORY_SCOPE_WORKGROUP);
            }
            int ln2 = (int)threadIdx.x & 63; asm volatile("" : "+v"(ln2)); const int rho2 = ln2 >> 4, l16b = ln2 & 15, kofs2 = 16 * l16b + 4 * rho2;
            u32x2 rw[4][8]; f32x4 gg[8];
#pragma unroll
            for (int j = 0; j < 8; ++j) gg[j] = *(const f32x4*)(A.in[I_GMOE] + j * 256 + kofs2);
#pragma unroll
            for (int t = 0; t < 4; ++t)
#pragma unroll
                for (int j = 0; j < 8; ++j) rw[t][j] = *(const u32x2*)(H1B + (size_t)((act ? mg : 0) * 4 + t) * DM + j * 256 + kofs2);
            __syncthreads();
            if (tid < NEXP) { const unsigned c = lcnt[tid]; lbase[tid] = c ? __hip_atomic_fetch_add(ctl + CW_CNT + tid, c, __ATOMIC_RELAXED, __HIP_MEMORY_SCOPE_AGENT) : 0u; lcnt[tid] = 0u; }
            __syncthreads();
            if (act) {
            int drow[4], rkk[4];
#pragma unroll
            for (int t = 0; t < 4; ++t) { rkk[t] = (int)lbase[sel_e[t]] + sel_r[t]; drow[t] = sel_e[t] * 16384 + rkk[t]; }
            if (ln2 < 4) {
#pragma unroll
                for (int t = 0; t < 4; ++t) { const int a_ = (mg * 4 + t) * 4 + ln2; TOKR[a_] = (u32x2){(unsigned)sel_e[t] | ((unsigned)rkk[t] << 8), __float_as_uint(sel_g[t])}; }
            }
            int dq[4][4];
#pragma unroll
            for (int t = 0; t < 4; ++t)
#pragma unroll
                for (int q = 0; q < 4; ++q) dq[t][q] = __shfl(drow[t], q);
#pragma unroll
            for (int t = 0; t < 4; ++t) {
                f32x4 vt[8]; const float r = rr[t];
#pragma unroll
                for (int j = 0; j < 8; ++j) { const u32x2 hw = rw[t][j]; vt[j] = (f32x4){bf_lo(hw.x) * r * gg[j][0], bf_hi(hw.x) * r * gg[j][1], bf_lo(hw.y) * r * gg[j][2], bf_hi(hw.y) * r * gg[j][3]}; }
                unsigned wq[8], sbj[8];
#pragma unroll
                for (int j = 0; j < 8; ++j) {
                    float am = fmaxf(fmaxf(fabsf(vt[j][0]), fabsf(vt[j][1])), fmaxf(fabsf(vt[j][2]), fabsf(vt[j][3])));
                    am = fmaxf(am, __uint_as_float((unsigned)__builtin_amdgcn_update_dpp(0, (int)__float_as_uint(am), 0xB1, 0xF, 0xF, true)));
                    am = max_x16_x32(am);
                    sbj[j] = mx_scale_byte(am); wq[j] = fp8x4_scaled(vt[j][0], vt[j][1], vt[j][2], vt[j][3], __uint_as_float(sbj[j] << 23));
                }
                unsigned sbs2[2];
#pragma unroll
                for (int jj = 0; jj < 2; ++jj) {
                    const auto s01 = __builtin_amdgcn_permlane16_swap(wq[4 * jj], wq[4 * jj + 1], false, false); const auto s23 = __builtin_amdgcn_permlane16_swap(wq[4 * jj + 2], wq[4 * jj + 3], false, false);
                    const auto t02 = __builtin_amdgcn_permlane32_swap(s01[0], s23[0], false, false); const auto t13 = __builtin_amdgcn_permlane32_swap(s01[1], s23[1], false, false);
                    const u32x4 o = {t02[0], t13[0], t02[1], t13[1]};
                    const size_t co = (size_t)(4 * jj + rho2) * 256 + 16 * l16b;
                    sbs2[jj] = rho2 == 0 ? sbj[4 * jj] : rho2 == 1 ? sbj[4 * jj + 1] : rho2 == 2 ? sbj[4 * jj + 2] : sbj[4 * jj + 3];
#pragma unroll
                    for (int q = 0; q < 4; ++q) *(u32x4*)(HNQL + (size_t)dq[t][q] * DM + co) = o;
                }
                { const int srcl = 16 * ((ln2 >> 3) & 3) + 2 * (ln2 & 7); const unsigned c0_ = (unsigned)__shfl((int)sbs2[0], srcl), c1_ = (unsigned)__shfl((int)sbs2[1], srcl); const unsigned cb = (ln2 >> 5) ? c1_ : c0_;
#pragma unroll
                  for (int q = 0; q < 4; ++q) HNSL[(size_t)dq[t][q] * 64 + ln2] = (unsigned char)cb; }
            }
            }
        }
        __syncthreads();
        if (BOTH(10)) GRID_BAR();
    }

#define BUILD_TSTART() do { if (wave == 0) { const int l_ = (int)threadIdx.x & 63; const int c_ = (l_ < NEXP) ? (int)__hip_atomic_load(ctl + CW_CNT + l_, __ATOMIC_RELAXED, __HIP_MEMORY_SCOPE_AGENT) : 0; const int n_ = (c_ + 255) >> 8; int in_ = n_; \
        _Pragma("unroll") for (int o_ = 1; o_ < 32; o_ <<= 1) { const int t_ = __shfl_up(in_, o_); if (l_ >= o_) in_ += t_; } \
        if (l_ < NEXP) tstart[l_] = in_ - n_; if (l_ == NEXP - 1) tstart[NEXP] = in_; } __syncthreads(); } while (0)

#define SLOT_PASS() do { \
        for (int a = bx * NTHREADS + tid; a < MTOK * TOPK; a += G * NTHREADS) { \
            const u32x2 rec_ = TOKR[a]; const int e = (int)(rec_.x & 255u), slot = tstart[e] * 256 + (int)(rec_.x >> 8); \
            TOK_SLOT[a] = slot; SLOT_TOK[slot] = a >> 2; SLOT_GATE[slot] = __uint_as_float(rec_.y); \
        } \
        for (int a = bx * NTHREADS + tid; a < NEXP * 256; a += G * NTHREADS) { \
            const int e = a >> 8, k = a & 255; const int cnt = (int)__hip_atomic_load(ctl + CW_CNT + e, __ATOMIC_RELAXED, __HIP_MEMORY_SCOPE_AGENT); \
            const int slot = tstart[e] * 256 + cnt + k; \
            if (slot < tstart[e + 1] * 256) { SLOT_TOK[slot] = 0; SLOT_GATE[slot] = 0.f; } \
        } } while (0)

    if (IN(12)) REP(12) {
        BUILD_TSTART();
        SLOT_PASS();
#if MOE_MX
        pg8::MoeOrder S{(const char*)HNQL, (const char*)W1Q, nullptr, tstart, 16, DM / 2, 4096, DM / 2, G, vcu, (const unsigned*)HNSL, (const unsigned*)W1S, 16, 1};
#if MOE_MX == 1
        EpiMoe1Q E{A.in[I_BE1], ACTQ, ACTS};
        pg8::gemm_phase_mx<EpiMoe1Q, pg8::MoeOrder, false>(lds, pg8::Dims{DM / 2, DM / 2, DM / 2}, S, E);
#else
        EpiMoe1 E{A.in[I_BE1], ACT};
        pg8::gemm_phase_mx<EpiMoe1, pg8::MoeOrder, true>(lds, pg8::Dims{DM / 2, DM / 2, DM / 2}, S, E);
#endif
#else
        pg8::MoeOrder S{(const char*)HN, (const char*)Wt_e1, SLOT_TOK, tstart, 16, DM, 4096, DM, G, vcu, nullptr, nullptr, 0};
        EpiMoe1 E{A.in[I_BE1], ACT};
        pg8::gemm_run<EpiMoe1, pg8::MoeOrder, true>(lds, pg8::Dims{DM, DM, DM}, S, E);
#endif
        if (BOTH(12)) GRID_BAR();
    }
    if (IN(13)) REP(13) {
        BUILD_TSTART();
#if MOE_MX == 1
        pg8::MoeOrder S{(const char*)ACTQ, (const char*)W2Q, nullptr, tstart, 8, DFF / 2, DM, DFF / 2, G, vcu, (const unsigned*)ACTS, (const unsigned*)W2S, 16, 0};
        EpiMoe2Q E{A.in[I_BE2], SLOT_GATE, YSQ, YSS};
        pg8::gemm_phase_mx<EpiMoe2Q, pg8::MoeOrder, false>(lds, pg8::Dims{DFF / 2, DFF / 2, DFF / 2}, S, E);
#else
        pg8::MoeOrder S{(const char*)ACT, (const char*)Wt_e2, nullptr, tstart, 8, DFF, DM, DFF, G, vcu, nullptr, nullptr, 0};
        EpiMoe2 E{A.in[I_BE2], SLOT_GATE, YS};
        pg8::gemm_run<EpiMoe2, pg8::MoeOrder, false>(lds, pg8::Dims{DFF, DFF, DFF}, S, E);
#endif
        if (BOTH(13)) GRID_BAR();
    }

    if (IN(14)) REP(14) {
        const int rho = lane >> 4, l16 = lane & 15, kofs = 16 * l16 + 4 * rho;
        for (int m = gw; m < MTOK; m += NGW) {
            const bf16_t* hrow = H1B + (size_t)m * DM; float* orow = A.out + (size_t)m * DM;
            const i32x4_t sl4 = *(const i32x4_t*)(TOK_SLOT + m * 4);
            f32x4 v[8];
#pragma unroll
            for (int j = 0; j < 8; ++j) { const u32x2 hw = *(const u32x2*)(hrow + j * 256 + kofs); v[j] = (f32x4){bf_lo(hw.x), bf_hi(hw.x), bf_lo(hw.y), bf_hi(hw.y)}; }
#pragma unroll
            for (int q = 0; q < 4; ++q) { const size_t sl = (size_t)sl4[q];
                const u32x2 sc = *(const u32x2*)(YSS + sl * 64 + (l16 >> 1) * 8);
#pragma unroll
                for (int jj = 0; jj < 2; ++jj) { const u32x4 y = *(const u32x4*)(YSQ + sl * DM + (size_t)(4 * jj + rho) * 256 + 16 * l16);
                    const auto s01 = __builtin_amdgcn_permlane16_swap(y.x, y.y, false, false); const auto s23 = __builtin_amdgcn_permlane16_swap(y.z, y.w, false, false);
                    const auto t02 = __builtin_amdgcn_permlane32_swap(s01[0], s23[0], false, false); const auto t13 = __builtin_amdgcn_permlane32_swap(s01[1], s23[1], false, false);
                    const unsigned w_[4] = {t02[0], t13[0], t02[1], t13[1]}; const unsigned sw = jj ? sc.y : sc.x;
#pragma unroll
                    for (int i = 0; i < 4; ++i) { const int j = 4 * jj + i; const float sc_ = __uint_as_float(((sw >> (8 * i)) & 0xffu) << 23);
                        const f32x2 lo_ = __builtin_amdgcn_cvt_pk_f32_fp8((int)w_[i], false), hi_ = __builtin_amdgcn_cvt_pk_f32_fp8((int)w_[i], true);
                        v[j][0] = fmaf(lo_[0], sc_, v[j][0]); v[j][1] = fmaf(lo_[1], sc_, v[j][1]); v[j][2] = fmaf(hi_[0], sc_, v[j][2]); v[j][3] = fmaf(hi_[1], sc_, v[j][3]); }
                } }
            float s = 0.f;
#pragma unroll
            for (int j = 0; j < 8; ++j) s += (v[j][0] * v[j][0] + v[j][1] * v[j][1]) + (v[j][2] * v[j][2] + v[j][3] * v[j][3]);
            const float r = 1.0f / sqrtf(wave_sum(s) * (1.0f / DM) + EPS);
#pragma unroll
            for (int j = 0; j < 8; ++j) { const f32x4 g = *(const f32x4*)(A.in[I_GFIN] + j * 256 + kofs);
                *(f32x4*)(orow + j * 256 + kofs) = (f32x4){v[j][0] * r * g[0], v[j][1] * r * g[1], v[j][2] * r * g[2], v[j][3] * r * g[3]}; }
        }
    }
#undef IN
#undef BOTH
}

extern "C" void kernel_launch(void* const* d_in, const int* in_sizes, int n_in, void* d_out, int out_size, void* d_ws, size_t ws_size, hipStream_t stream) {
    static int grid = 0;
    if (grid == 0) {
        if (n_in != 35 || in_sizes[0] != MTOK * DM || out_size != MTOK * DM || ws_size < WS_END) { fprintf(stderr, "kernel_launch: unexpected shapes (n_in %d, in0 %d, out %d, ws %zu)\n", n_in, n_in > 0 ? in_sizes[0] : -1, out_size, ws_size); grid = -1; return; }
        int dev = 0, cus = 0;
        if (hipGetDevice(&dev) != hipSuccess || hipDeviceGetAttribute(&cus, hipDeviceAttributeMultiprocessorCount, dev) != hipSuccess) { grid = -1; return; }
        if (hipFuncSetAttribute((const void*)mk_fwd, hipFuncAttributeMaxDynamicSharedMemorySize, LDS_BYTES) != hipSuccess) { fprintf(stderr, "kernel_launch: hipFuncSetAttribute failed\n"); grid = -1; return; }
        int per_cu = 0;
        if (hipOccupancyMaxActiveBlocksPerMultiprocessor(&per_cu, (const void*)mk_fwd, NTHREADS, LDS_BYTES) != hipSuccess || per_cu < 1) fprintf(stderr, "kernel_launch: occupancy query says %d\n", per_cu);
        (void)hipGetLastError();
        grid = cus;
    }
    if (grid < 0) return;
    (void)hipMemsetAsync((char*)d_ws + WS_CTL, 0, CTL_ZERO_BYTES, stream);
    Args a{};
    for (int i = 0; i < 35; ++i) a.in[i] = (const float*)d_in[i];
    a.out = (float*)d_out; a.ws = (unsigned char*)d_ws;
#if MK_FUSED
    a.ph_lo = 0; a.ph_hi = NPHASE;
    hipLaunchKernelGGL(mk_fwd, dim3(grid), dim3(NTHREADS), LDS_BYTES, stream, a);
#else
    for (int p = 0; p < NPHASE; ++p) { a.ph_lo = p; a.ph_hi = p + 1; hipLaunchKernelGGL(mk_fwd, dim3(grid), dim3(NTHREADS), LDS_BYTES, stream, a); }
#endif
    const hipError_t le = hipPeekAtLastError();
    if (le != hipSuccess) fprintf(stderr, "kernel_launch: launch failed: %s\n", hipGetErrorName(le));
}
```
